# Optimizing an MI355X kernel written in HIP

```python
import math, functools
import jax, jax.numpy as jnp
from jax import lax
import numpy as np

D_MODEL = 1024
BATCH = 16
SEQ = 2048
DEPTH = 2
DEC_BATCH = 8
DEC_SEQ = 32
PAST_LEN = 2048

CHUNK = 64
LEFT_CHUNKS = 8
BAND_PAST = LEFT_CHUNKS * CHUNK
BAND = BAND_PAST + CHUNK
D_ATTN = D_MODEL // 2
HEAD_DIM = 64
N_HEADS = D_ATTN // HEAD_DIM
REL_CLIP = 128
N_REL = 2 * REL_CLIP + 1
D_POOL = D_MODEL // 2
POOL_WINDOWS = (2, 4, 8, 16)
N_POOL_GRP = len(POOL_WINDOWS)
POOL_GRP = D_POOL // N_POOL_GRP
POOL_PAD = max(POOL_WINDOWS) - 1
N_BRANCH = 2
IN_COLS = D_POOL + 3 * D_ATTN + N_BRANCH * D_MODEL
D_FF = 2816
CONV_W = 3
PLE_DIM = 256
EPS = 1e-6
NEG_INF = -1e30

kernel_name = "hybrid_pool_chunkattn_streaming_encoder_step"


def rmsnorm(x, g):
    xf = x.astype(jnp.float32)
    y = xf * lax.rsqrt(jnp.mean(xf * xf, axis=-1, keepdims=True) + EPS)
    return (y * g.astype(jnp.float32)).astype(x.dtype)


def pool_mixer(u, buf, pos0, w_grp, scale):
    B, L, _ = u.shape
    full = jnp.concatenate([buf, u], axis=1)
    ff = full.astype(jnp.float32)
    cs = jnp.concatenate([jnp.zeros_like(ff[:, :1]), jnp.cumsum(ff, axis=1)], axis=1)
    pos = pos0 + jnp.arange(L, dtype=jnp.int32)
    means = []
    for g, w in enumerate(POOL_WINDOWS):
        sl = slice(g * POOL_GRP, (g + 1) * POOL_GRP)
        end = cs[:, POOL_PAD + 1:POOL_PAD + 1 + L, sl]
        start = cs[:, POOL_PAD + 1 - w:POOL_PAD + 1 - w + L, sl]
        cnt = jnp.minimum(pos + 1, w).astype(jnp.float32)[None, :, None]
        means.append((end - start) / cnt)
    d = (jnp.concatenate(means, axis=-1) - u.astype(jnp.float32)).astype(u.dtype)
    d = d.reshape(B, L, N_POOL_GRP, POOL_GRP)
    y = jnp.einsum('blgc,gcd->blgd', d, w_grp).reshape(B, L, D_POOL) * scale
    return y, full[:, -POOL_PAD:]


def band_attend(q, k, v, q_pos, k_pos, k_valid, rel_bias):
    s = jnp.einsum('bqhd,bkhd->bhqk', q, k).astype(jnp.float32) * (HEAD_DIM ** -0.5)
    rel = jnp.clip(q_pos[:, None] - k_pos[None, :], -REL_CLIP, REL_CLIP) + REL_CLIP
    s = s + rel_bias[:, rel].astype(jnp.float32)[None]
    s = jnp.where(k_valid[None, None, None, :], s, NEG_INF)
    p = jax.nn.softmax(s, axis=-1)
    return jnp.einsum('bhqk,bkhd->bqhd', p.astype(v.dtype), v)


def chunk_attention_prompt(q, k, v, rel_bias):
    B, L, H, Dh = q.shape
    n_chunks = L // CHUNK
    pad = jnp.zeros((B, BAND_PAST, H, Dh), k.dtype)
    k_pad = jnp.concatenate([pad, k], axis=1)
    v_pad = jnp.concatenate([pad, v], axis=1)

    def one_chunk(c):
        start = c * CHUNK
        q_c = lax.dynamic_slice_in_dim(q, start, CHUNK, axis=1)
        k_b = lax.dynamic_slice_in_dim(k_pad, start, BAND, axis=1)
        v_b = lax.dynamic_slice_in_dim(v_pad, start, BAND, axis=1)
        q_pos = start + jnp.arange(CHUNK, dtype=jnp.int32)
        k_pos = start - BAND_PAST + jnp.arange(BAND, dtype=jnp.int32)
        return band_attend(q_c, k_b, v_b, q_pos, k_pos, k_pos >= 0, rel_bias)

    out = lax.map(one_chunk, jnp.arange(n_chunks, dtype=jnp.int32))
    out = jnp.moveaxis(out, 0, 1).reshape(B, L, H * Dh)
    keep = min(BAND_PAST, L)
    return out, k[:, L - keep:], v[:, L - keep:]


def chunk_attention_sample(q, k, v, cache_k, cache_v, rel_bias):
    B, L, H, Dh = q.shape
    n_c = cache_k.shape[1]
    k_all = jnp.concatenate([cache_k, k], axis=1)
    v_all = jnp.concatenate([cache_v, v], axis=1)
    q_pos = PAST_LEN + jnp.arange(L, dtype=jnp.int32)
    k_pos = jnp.concatenate([PAST_LEN - n_c + jnp.arange(n_c, dtype=jnp.int32), q_pos])
    out = band_attend(q, k_all, v_all, q_pos, k_pos, k_pos >= 0, rel_bias).reshape(B, L, H * Dh)
    return out, k, v


def conv_ffn(h, buf, w_up, w_dw, b_dw, w_down):
    L = h.shape[1]
    up = h @ w_up
    a, b = jnp.split(up, 2, axis=-1)
    full = jnp.concatenate([buf, a], axis=1)
    conv = b_dw + sum(full[:, t:t + L] * w_dw[t] for t in range(CONV_W))
    y = (jax.nn.gelu(conv) * b) @ w_down
    return y, full[:, -(CONV_W - 1):]


def trunk_layer(x, p_i, pool_buf, conv_buf, pos0, attn_fn, lw):
    (g_mix, w_in, b_gate, w_pool_grp, pool_scale, w_pool_proj, w_attn_proj, w_out,
     g_ffn, w_up, w_dw, b_dw, w_down, g_ple, w_ple, w_ple_gate) = lw
    B, L, _ = x.shape
    h = rmsnorm(x, g_mix)
    z = h @ w_in
    u, q, k, v, gl = jnp.split(
        z, [D_POOL, D_POOL + D_ATTN, D_POOL + 2 * D_ATTN, D_POOL + 3 * D_ATTN], axis=-1)
    g_pool, g_attn = jnp.split(jax.nn.sigmoid(gl + b_gate), 2, axis=-1)
    pool_out, new_pool = pool_mixer(u, pool_buf, pos0, w_pool_grp, pool_scale)
    attn_out, new_k, new_v = attn_fn(q.reshape(B, L, N_HEADS, HEAD_DIM),
                                     k.reshape(B, L, N_HEADS, HEAD_DIM),
                                     v.reshape(B, L, N_HEADS, HEAD_DIM))
    merged = g_pool * (pool_out @ w_pool_proj) + g_attn * (attn_out @ w_attn_proj)
    x = x + merged @ w_out
    ffn_out, new_conv = conv_ffn(rmsnorm(x, g_ffn), conv_buf, w_up, w_dw, b_dw, w_down)
    x = x + ffn_out
    x = x + (p_i @ w_ple) * jax.nn.sigmoid(rmsnorm(x, g_ple) @ w_ple_gate)
    return x, new_pool, new_k, new_v, new_conv


def setup_inputs(seed: int = 0) -> dict:
    key = jax.random.key(seed)
    ks = jax.random.split(key, 32)

    def nrm(k, shape, scale=1.0):
        return jax.random.normal(k, shape, jnp.float32) * scale

    n_cache_att = min(BAND_PAST, PAST_LEN)
    return {
        "x_prompt": nrm(ks[0], (BATCH, SEQ, D_MODEL)),
        "x_sample": nrm(ks[1], (DEC_BATCH, DEC_SEQ, D_MODEL)),
        "cache_pool": nrm(ks[2], (DEPTH, DEC_BATCH, POOL_PAD, D_POOL)),
        "cache_k": nrm(ks[3], (DEPTH, DEC_BATCH, n_cache_att, N_HEADS, HEAD_DIM)),
        "cache_v": nrm(ks[4], (DEPTH, DEC_BATCH, n_cache_att, N_HEADS, HEAD_DIM)),
        "cache_ffn_conv": nrm(ks[5], (DEPTH, DEC_BATCH, CONV_W - 1, D_FF)),
        "p_prompt": nrm(ks[6], (DEPTH, BATCH, SEQ, PLE_DIM)),
        "p_sample": nrm(ks[7], (DEPTH, DEC_BATCH, DEC_SEQ, PLE_DIM)),
        "g_mix": 1.0 + nrm(ks[8], (DEPTH, D_MODEL), 0.02),
        "w_in": nrm(ks[9], (DEPTH, D_MODEL, IN_COLS), D_MODEL ** -0.5),
        "b_gate": nrm(ks[10], (DEPTH, N_BRANCH * D_MODEL), 0.02),
        "w_pool_grp": nrm(ks[11], (DEPTH, N_POOL_GRP, POOL_GRP, POOL_GRP), POOL_GRP ** -0.5),
        "pool_scale": 1.0 + nrm(ks[12], (DEPTH, D_POOL), 0.02),
        "rel_bias": nrm(ks[13], (DEPTH, N_HEADS, N_REL), 0.5),
        "w_pool_proj": nrm(ks[14], (DEPTH, D_POOL, D_MODEL), D_POOL ** -0.5),
        "w_attn_proj": nrm(ks[15], (DEPTH, D_ATTN, D_MODEL), D_ATTN ** -0.5),
        "w_out": nrm(ks[16], (DEPTH, D_MODEL, D_MODEL), D_MODEL ** -0.5),
        "g_ffn": 1.0 + nrm(ks[17], (DEPTH, D_MODEL), 0.02),
        "w_up": nrm(ks[18], (DEPTH, D_MODEL, 2 * D_FF), D_MODEL ** -0.5),
        "w_dw": nrm(ks[19], (DEPTH, CONV_W, D_FF), CONV_W ** -0.5),
        "b_dw": nrm(ks[20], (DEPTH, D_FF), 0.02),
        "w_down": nrm(ks[21], (DEPTH, D_FF, D_MODEL), D_FF ** -0.5),
        "g_ple": 1.0 + nrm(ks[22], (DEPTH, D_MODEL), 0.02),
        "w_ple": nrm(ks[23], (DEPTH, PLE_DIM, D_MODEL), PLE_DIM ** -0.5),
        "w_ple_gate": nrm(ks[24], (DEPTH, D_MODEL, D_MODEL), D_MODEL ** -0.5),
        "g_final": 1.0 + nrm(ks[25], (D_MODEL,), 0.02),
    }


def reference(x_prompt, x_sample, cache_pool, cache_k, cache_v, cache_ffn_conv, p_prompt, p_sample,
              g_mix, w_in, b_gate, w_pool_grp, pool_scale, rel_bias, w_pool_proj, w_attn_proj, w_out,
              g_ffn, w_up, w_dw, b_dw, w_down, g_ple, w_ple, w_ple_gate, g_final):
    xp, xs = x_prompt, x_sample
    B = xp.shape[0]
    pool_p, k_p, v_p, conv_p = [], [], [], []
    pool_s, k_s, v_s, conv_s = [], [], [], []
    for i in range(DEPTH):
        lw = (g_mix[i], w_in[i], b_gate[i], w_pool_grp[i], pool_scale[i], w_pool_proj[i],
              w_attn_proj[i], w_out[i], g_ffn[i], w_up[i], w_dw[i], b_dw[i], w_down[i],
              g_ple[i], w_ple[i], w_ple_gate[i])
        xp, a1, a2, a3, a4 = trunk_layer(
            xp, p_prompt[i],
            jnp.zeros((B, POOL_PAD, D_POOL), xp.dtype),
            jnp.zeros((B, CONV_W - 1, D_FF), xp.dtype),
            0,
            functools.partial(chunk_attention_prompt, rel_bias=rel_bias[i]),
            lw)
        pool_p.append(a1); k_p.append(a2); v_p.append(a3); conv_p.append(a4)
        xs, b1, b2, b3, b4 = trunk_layer(
            xs, p_sample[i], cache_pool[i], cache_ffn_conv[i], PAST_LEN,
            functools.partial(chunk_attention_sample, cache_k=cache_k[i], cache_v=cache_v[i],
                              rel_bias=rel_bias[i]),
            lw)
        pool_s.append(b1); k_s.append(b2); v_s.append(b3); conv_s.append(b4)
    y_prompt = rmsnorm(xp, g_final)
    y_sample = rmsnorm(xs, g_final)
    new_pool_prompt = jnp.stack(pool_p)
    new_k_prompt = jnp.stack(k_p)
    new_v_prompt = jnp.stack(v_p)
    new_conv_prompt = jnp.stack(conv_p)
    new_pool_sample = jnp.stack(pool_s)
    new_k_sample = jnp.stack(k_s)
    new_v_sample = jnp.stack(v_s)
    new_conv_sample = jnp.stack(conv_s)
    return (y_prompt, y_sample, new_pool_prompt, new_k_prompt, new_v_prompt, new_conv_prompt,
            new_pool_sample, new_k_sample, new_v_sample, new_conv_sample)
```

```cpp
#include <hip/hip_runtime.h>
#include <hip/hip_cooperative_groups.h>
#include <cstdio>
#include <cstdint>
namespace cg = cooperative_groups;
namespace pg8 {
#define PG8_LAS __attribute__((address_space(3)))
typedef unsigned short bf16_t;
typedef short bf16x8 __attribute__((ext_vector_type(8)));
typedef float f32x4 __attribute__((ext_vector_type(4)));
typedef unsigned u32x4 __attribute__((ext_vector_type(4)));
constexpr int BM = 256, BK = 64, HALF = 128, HTB = HALF * BK * 2  , STAGE_BYTES = 8 * HTB, NXCD = 8, WGM = 8;

__host__ __device__ __forceinline__ int lds_byte(int r, int c) { const int st = (r >> 4) * 2 + (c >> 5), rr = r & 15, cc = c & 31, ob = rr * 64 + cc * 2; return st * 1024 + (ob ^ (((ob >> 9) & 1) << 5)); }
__host__ __device__ __forceinline__ void stage_rc(int b, int& R, int& C) { const int st = b / 1024, sb = b % 1024, swz = sb ^ (((sb >> 9) & 1) << 5); R = (st >> 1) * 16 + swz / 64; C = (st & 1) * 32 + (swz % 64) / 2; }
__host__ __device__ __forceinline__ int perm32(int rho) { const int n = rho >> 4, i = rho & 15; return 8 * (i >> 2) + 4 * n + (i & 3); }

struct Unit { int pm, pn; };
struct Gemm { const bf16_t* A; const bf16_t* Bt; int M, N, K; };

struct StaticOrder {
    int nM, nN, nwg, G, c;
    __host__ __device__ void init(int M, int N, int G_, int c_) { nM = M / BM; nN = N / BM; nwg = nM * nN; G = G_; c = c_; }
    __host__ __device__ bool next(int i, Unit& u) const {
        const long L = (long)i * G + c; if (L >= nwg) return false;
        int wgid = (int)L; { const int q = nwg / NXCD, r = nwg % NXCD, xcd = wgid % NXCD, off = wgid / NXCD; wgid = (xcd < r ? xcd * (q + 1) : r * (q + 1) + (xcd - r) * q) + off; }
        const int nig = WGM * nN, gid = wgid / nig, fm = gid * WGM, gsz = (nM - fm) < WGM ? (nM - fm) : WGM;
        u.pm = fm + ((wgid % nig) % gsz); u.pn = (wgid % nig) / gsz; return true;
    }
    __device__ __forceinline__ void a_ready(const Unit&) const {}
    __device__ __forceinline__ void done(const Unit&) const {}
};


constexpr int DM = 1024, NBATCH = 16, SEQ = 2048, DBATCH = 8, DSEQ = 32;
constexpr int MP = NBATCH * SEQ, MS = DBATCH * DSEQ, MT = MP + MS;
constexpr int DFF = 2816, KCACHE = 512, KS_ROWS = KCACHE + DSEQ;
constexpr size_t O_YP = 0, O_YS = (size_t)MP * DM, O_POOLP = O_YS + (size_t)MS * DM, O_KP = O_POOLP + 2 * 16 * 15 * 512,
                 O_VP = O_KP + (size_t)2 * 16 * 512 * 512, O_CONVP = O_VP + (size_t)2 * 16 * 512 * 512, O_POOLS = O_CONVP + 2 * 16 * 2 * 2816,
                 O_KS = O_POOLS + 2 * 8 * 15 * 512, O_VS = O_KS + 2 * 8 * 32 * 512, O_CONVS = O_VS + 2 * 8 * 32 * 512, O_END = O_CONVS + 2 * 8 * 2 * 2816;

constexpr size_t MiB = 1u << 20;
constexpr size_t WL_IN = 0, WL_C = 8 * MiB, WL_AP = 9 * MiB, WL_OUT = 10 * MiB, WL_UP = 12 * MiB, WL_DOWN = 23 * MiB, WL_PLE = 29 * MiB  , WL_PG = 30 * MiB, WL_SIZE = 32 * MiB;
static_assert(WL_DOWN + (size_t)1024 * 2816 * 2 <= WL_PLE && WL_UP + (size_t)5632 * 1024 * 2 <= WL_DOWN, "weights map");
constexpr size_t WS_W = 1 * MiB;
constexpr size_t WS_HB = WS_W + 2 * WL_SIZE;
constexpr size_t WS_R = WS_HB + 65 * MiB;
constexpr size_t R_U = 0, R_Q = 33 * MiB, R_K = 66 * MiB, R_VT = 99 * MiB, R_G = 131 * MiB, R_D = 260 * MiB, R_KS = 293 * MiB, R_VTS = 298 * MiB;
constexpr size_t R_A = 0, R_ACT = 178 * MiB;
constexpr size_t R_PB = 0, R_T = 17 * MiB, R_HB3 = 82 * MiB;
constexpr size_t R_STG = 303 * MiB, R_STG2 = 357 * MiB;
constexpr size_t R_MG = 303 * MiB;
constexpr size_t WS_END = WS_R + 368 * MiB;
static_assert((size_t)MT * 2816 * 2 <= 178 * MiB && (size_t)MT * 2048 * 2 <= 129 * MiB && (size_t)MT * 512 * 2 <= 33 * MiB && (size_t)MT * 1024 * 2 <= 65 * MiB, "ws map");
static_assert(WS_END <= 512 * MiB, "ws budget");

constexpr size_t S_POOLP = 0, S_KP = 16 * 15 * 512, S_VP = S_KP + (size_t)16 * 512 * 512, S_POOLS = S_VP + (size_t)16 * 512 * 512, S_KS = S_POOLS + 8 * 15 * 512, S_VS = S_KS + 8 * 32 * 512, S_END = S_VS + 8 * 32 * 512;
constexpr size_t S_CONVP = 0, S_CONVS = 16 * 2 * 2816, S_CEND = S_CONVS + 8 * 2 * 2816;
typedef float f32x2 __attribute__((ext_vector_type(2)));
__device__ __forceinline__ unsigned cvt_pk_bf16(float lo, float hi) { unsigned r; asm volatile("v_cvt_pk_bf16_f32 %0, %1, %2" : "=v"(r) : "v"(lo), "v"(hi)); return r; }
__device__ __forceinline__ float bflo(unsigned u) { return __uint_as_float(u << 16); }
__device__ __forceinline__ float bfhi(unsigned u) { return __uint_as_float(u & 0xffff0000u); }
__device__ __forceinline__ float sigmoidf_(float x) { return __builtin_amdgcn_rcpf(1.0f + __builtin_amdgcn_exp2f(-1.4426950408889634f * x)); }
__device__ __forceinline__ float gelu_tanh(float x) { const float u = 1.5957691216057308f * x * (1.0f + 0.044715f * x * x); return x * sigmoidf_(u); }
__device__ __forceinline__ u32x4 pack8(const f32x4 a, const f32x4 b) { u32x4 w; w.x = cvt_pk_bf16(a[0], a[1]); w.y = cvt_pk_bf16(a[2], a[3]); w.z = cvt_pk_bf16(b[0], b[1]); w.w = cvt_pk_bf16(b[2], b[3]); return w; }
__device__ __forceinline__ void unpack8(const u32x4 w, f32x4& a, f32x4& b) { a = (f32x4){bflo(w.x), bfhi(w.x), bflo(w.y), bfhi(w.y)}; b = (f32x4){bflo(w.z), bfhi(w.z), bflo(w.w), bfhi(w.w)}; }

#define EPI_LOOP_BEGIN asm volatile("" : "+v"(fr), "+v"(fq));     \
    _Pragma("unroll") for (int ai = 0; ai < 2; ++ai) _Pragma("unroll") for (int m = 0; m < 4; ++m) { const int row = u.pm * BM + ai * HALF + wr * 64 + m * 16 + fr; \
    _Pragma("unroll") for (int bj = 0; bj < 2; ++bj) { const int c = u.pn * BM + bj * HALF + wc * 32 + 8 * fq; f32x4 v0 = acc[ai][bj][m][0], v1 = acc[ai][bj][m][1];
#define EPI_LOOP_END } asm volatile("" ::: "memory"); }

struct EpiG1 {
    static constexpr bool PERM = true, AFTER_DRAIN = false;
    unsigned char* wsb; const float* bgate; int layer;
    __device__ __forceinline__ void operator()(const f32x4 (&acc)[2][2][4][2], const Unit& u, int wr, int wc, int fr, int fq) const {
        const int kind = u.pn < 8 ? (u.pn >> 1) : 4; const bool samp = u.pm >= MP / BM;
        unsigned char* wsb = this->wsb; asm volatile("" : "+s"(wsb));
        bf16_t* const U = (bf16_t*)(wsb + WS_R + R_U); bf16_t* const Q = (bf16_t*)(wsb + WS_R + R_Q); bf16_t* const Kp = (bf16_t*)(wsb + WS_R + R_K); bf16_t* const Vtp = (bf16_t*)(wsb + WS_R + R_VT);
        bf16_t* const Ks = (bf16_t*)(wsb + WS_R + R_KS); bf16_t* const Vts = (bf16_t*)(wsb + WS_R + R_VTS); bf16_t* const G = (bf16_t*)(wsb + WS_R + R_G); float* const out = (float*)(wsb + WS_R + R_STG);
        EPI_LOOP_BEGIN
            int b, t; if (samp) { const int rs = row - MP; b = rs >> 5; t = rs & 31; } else { b = row >> 11; t = row & 2047; }
            if (kind == 0) {
                *(u32x4*)(U + (size_t)row * 512 + c) = pack8(v0, v1);
                if (!samp) { if (t >= SEQ - 15) { float* o = out + S_POOLP + ((size_t)b * 15 + (t - (SEQ - 15))) * 512 + c; *(f32x4*)o = v0; *(f32x4*)(o + 4) = v1; } }
                else { if (t >= DSEQ - 15) { float* o = out + S_POOLS + ((size_t)b * 15 + (t - (DSEQ - 15))) * 512 + c; *(f32x4*)o = v0; *(f32x4*)(o + 4) = v1; } }
            } else if (kind == 1) {
                *(u32x4*)(Q + (size_t)row * 512 + (c - 512)) = pack8(v0 * 0.125f, v1 * 0.125f);
            } else if (kind == 2) {
                const int ck = c - 1024;
                if (!samp) { *(u32x4*)(Kp + (size_t)row * 512 + ck) = pack8(v0, v1);
                    if (t >= SEQ - 512) { float* o = out + S_KP + ((size_t)b * 512 + (t - (SEQ - 512))) * 512 + ck; *(f32x4*)o = v0; *(f32x4*)(o + 4) = v1; } }
                else { *(u32x4*)(Ks + ((size_t)b * KS_ROWS + KCACHE + t) * 512 + ck) = pack8(v0, v1);
                    float* o = out + S_KS + ((size_t)b * 32 + t) * 512 + ck; *(f32x4*)o = v0; *(f32x4*)(o + 4) = v1; }
            } else if (kind == 3) {
                const int cv = c - 1536, h = cv >> 6, d0 = cv & 63; const u32x4 w = pack8(v0, v1);
                bf16_t* vb; size_t pitch;
                if (!samp) { vb = Vtp + ((size_t)(b * 8 + h) * 64 + d0) * SEQ + t; pitch = SEQ;
                    if (t >= SEQ - 512) { float* o = out + S_VP + ((size_t)b * 512 + (t - (SEQ - 512))) * 512 + cv; *(f32x4*)o = v0; *(f32x4*)(o + 4) = v1; } }
                else { vb = Vts + ((size_t)(b * 8 + h) * 64 + d0) * KS_ROWS + KCACHE + t; pitch = KS_ROWS;
                    float* o = out + S_VS + ((size_t)b * 32 + t) * 512 + cv; *(f32x4*)o = v0; *(f32x4*)(o + 4) = v1; }
                vb[0 * pitch] = (bf16_t)(w.x & 0xffffu); vb[1 * pitch] = (bf16_t)(w.x >> 16); vb[2 * pitch] = (bf16_t)(w.y & 0xffffu); vb[3 * pitch] = (bf16_t)(w.y >> 16);
                vb[4 * pitch] = (bf16_t)(w.z & 0xffffu); vb[5 * pitch] = (bf16_t)(w.z >> 16); vb[6 * pitch] = (bf16_t)(w.w & 0xffffu); vb[7 * pitch] = (bf16_t)(w.w >> 16);
            } else {
                const int cgt = c - 2048; const f32x4 b0 = *(const f32x4*)(bgate + cgt), b1 = *(const f32x4*)(bgate + cgt + 4);
                v0 = v0 + b0; v1 = v1 + b1;
                _Pragma("unroll") for (int j = 0; j < 4; ++j) { v0[j] = sigmoidf_(v0[j]); v1[j] = sigmoidf_(v1[j]); }
                *(u32x4*)(G + (size_t)row * 2048 + cgt) = pack8(v0, v1);
            }
        EPI_LOOP_END
    }
};
template <int MODE> struct EpiGate {
    static constexpr bool PERM = true, AFTER_DRAIN = false;
    bf16_t* O; int ldc; const bf16_t* G; int goff;
    __device__ __forceinline__ void operator()(const f32x4 (&acc)[2][2][4][2], const Unit& u, int wr, int wc, int fr, int fq) const {
        EPI_LOOP_BEGIN
            bf16_t* op = O + (size_t)row * ldc + c;
            if (MODE >= 1) { f32x4 g0, g1; unpack8(*(const u32x4*)(G + (size_t)row * 2048 + goff + c), g0, g1); v0 = v0 * g0; v1 = v1 * g1; }
            if (MODE == 2) { f32x4 p0, p1; unpack8(*(const u32x4*)op, p0, p1); v0 = v0 + p0; v1 = v1 + p1; }
            *(u32x4*)op = pack8(v0, v1);
        EPI_LOOP_END
    }
};
struct EpiRes {
    static constexpr bool PERM = true, AFTER_DRAIN = false;
    const float* bp; const float* bs; float* X;
    __device__ __forceinline__ void operator()(const f32x4 (&acc)[2][2][4][2], const Unit& u, int wr, int wc, int fr, int fq) const {
        const float* base = u.pm >= MP / BM ? bs - (size_t)MP * DM : bp;
        asm volatile("" : "+v"(fr), "+v"(fq));
        const size_t off0 = (size_t)(u.pm * BM + wr * 64 + fr) * DM + u.pn * BM + wc * 32 + 8 * fq;
        f32x4 cur[2][2], nxt[2][2];
#pragma unroll
        for (int bj = 0; bj < 2; ++bj) { cur[bj][0] = *(const f32x4*)(base + off0 + bj * HALF); cur[bj][1] = *(const f32x4*)(base + off0 + bj * HALF + 4); }
#pragma unroll
        for (int it = 0; it < 8; ++it) { const int ai = it >> 2, m = it & 3; const size_t off = off0 + (size_t)(ai * HALF + m * 16) * DM;
            if (it < 7) { const size_t offn = off0 + (size_t)(((it + 1) >> 2) * HALF + ((it + 1) & 3) * 16) * DM;
#pragma unroll
                for (int bj = 0; bj < 2; ++bj) { nxt[bj][0] = *(const f32x4*)(base + offn + bj * HALF); nxt[bj][1] = *(const f32x4*)(base + offn + bj * HALF + 4); } }
#pragma unroll
            for (int bj = 0; bj < 2; ++bj) { *(f32x4*)(X + off + bj * HALF) = cur[bj][0] + acc[ai][bj][m][0]; *(f32x4*)(X + off + bj * HALF + 4) = cur[bj][1] + acc[ai][bj][m][1]; }
#pragma unroll
            for (int bj = 0; bj < 2; ++bj) { cur[bj][0] = nxt[bj][0]; cur[bj][1] = nxt[bj][1]; }
            asm volatile("" ::: "memory"); }
    }
};
struct EpiPle {
    static constexpr bool PERM = true, AFTER_DRAIN = false;
    const bf16_t* T; float* X;
    __device__ __forceinline__ void operator()(const f32x4 (&acc)[2][2][4][2], const Unit& u, int wr, int wc, int fr, int fq) const {
        EPI_LOOP_BEGIN
            const size_t off = (size_t)row * DM + c; f32x4 t0, t1; unpack8(*(const u32x4*)(T + off), t0, t1);
            f32x4 x0 = *(const f32x4*)(X + off), x1 = *(const f32x4*)(X + off + 4);
            _Pragma("unroll") for (int j = 0; j < 4; ++j) { x0[j] += t0[j] * sigmoidf_(v0[j]); x1[j] += t1[j] * sigmoidf_(v1[j]); }
            *(f32x4*)(X + off) = x0; *(f32x4*)(X + off + 4) = x1;
        EPI_LOOP_END
    }
};
struct EpiUpA {
    static constexpr bool PERM = true, AFTER_DRAIN = false;
    bf16_t* A; float* out; int layer;
    __device__ __forceinline__ void operator()(const f32x4 (&acc)[2][2][4][2], const Unit& u, int wr, int wc, int fr, int fq) const {
        const bool samp = u.pm >= MP / BM;
        EPI_LOOP_BEGIN
            *(u32x4*)(A + (size_t)row * DFF + c) = pack8(v0, v1);
            if (!samp) { const int b = row >> 11, t = row & 2047; if (t >= SEQ - 2) { float* o = out + S_CONVP + ((size_t)b * 2 + (t - (SEQ - 2))) * DFF + c; *(f32x4*)o = v0; *(f32x4*)(o + 4) = v1; } }
            else { const int rs = row - MP, b = rs >> 5, t = rs & 31; if (t >= DSEQ - 2) { float* o = out + S_CONVS + ((size_t)b * 2 + (t - (DSEQ - 2))) * DFF + c; *(f32x4*)o = v0; *(f32x4*)(o + 4) = v1; } }
        EPI_LOOP_END
    }
};
struct EpiUpB {
    static constexpr bool PERM = true, AFTER_DRAIN = false;
    const bf16_t* A; bf16_t* ACT; const float* wdw; const float* bdw; const float* cconv;
    __device__ __forceinline__ void operator()(const f32x4 (&acc)[2][2][4][2], const Unit& u, int wr, int wc, int fr, int fq) const {
        const bool samp = u.pm >= MP / BM;
        EPI_LOOP_BEGIN
            int b, t; if (samp) { const int rs = row - MP; b = rs >> 5; t = rs & 31; } else { b = row >> 11; t = row & 2047; }
            const bf16_t* ap = A + (size_t)row * DFF + c;
            f32x4 a00, a01, a10, a11, a20, a21;
            unpack8(*(const u32x4*)ap, a00, a01);
            if (t >= 1) unpack8(*(const u32x4*)(ap - DFF), a10, a11);
            else if (samp) { const float* cp = cconv + ((size_t)b * 2 + 1) * DFF + c; a10 = *(const f32x4*)cp; a11 = *(const f32x4*)(cp + 4); }
            else { a10 = (f32x4){0.f, 0.f, 0.f, 0.f}; a11 = a10; }
            if (t >= 2) unpack8(*(const u32x4*)(ap - 2 * DFF), a20, a21);
            else if (samp) { const float* cp = cconv + ((size_t)b * 2 + t) * DFF + c; a20 = *(const f32x4*)cp; a21 = *(const f32x4*)(cp + 4); }
            else { a20 = (f32x4){0.f, 0.f, 0.f, 0.f}; a21 = a20; }
            const f32x4 w00 = *(const f32x4*)(wdw + c), w01 = *(const f32x4*)(wdw + c + 4), w10 = *(const f32x4*)(wdw + DFF + c), w11 = *(const f32x4*)(wdw + DFF + c + 4),
                        w20 = *(const f32x4*)(wdw + 2 * DFF + c), w21 = *(const f32x4*)(wdw + 2 * DFF + c + 4), bb0 = *(const f32x4*)(bdw + c), bb1 = *(const f32x4*)(bdw + c + 4);
            f32x4 s0 = bb0 + w00 * a20 + w10 * a10 + w20 * a00, s1 = bb1 + w01 * a21 + w11 * a11 + w21 * a01;
            _Pragma("unroll") for (int j = 0; j < 4; ++j) { s0[j] = gelu_tanh(s0[j]) * v0[j]; s1[j] = gelu_tanh(s1[j]) * v1[j]; }
            *(u32x4*)(ACT + (size_t)row * DFF + c) = pack8(s0, s1);
        EPI_LOOP_END
    }
};

template <class Epi, class Sched, bool ALIGN_EPI = false, bool SP2 = false>
__device__ __forceinline__ void gemm_phase(PG8_LAS unsigned char* lds, const Gemm g, const Sched& S, const Epi& E) {
    int tid_ = threadIdx.x; asm volatile("" : "+v"(tid_));
    const int tid = tid_, wid = __builtin_amdgcn_readfirstlane(tid >> 6), lane = tid & 63, wr = wid >> 2, wc = wid & 3, fr = lane & 15, fq = lane >> 4;
    int K_ = g.K; if (g.K < 512) asm volatile("" : "+s"(K_));
    const int K = K_, nt = K / BK;
    unsigned voffA[2], voffB[2];
#pragma unroll
    for (int i = 0; i < 2; ++i) { int R, C; stage_rc(tid * 16 + i * 8192, R, C); const int Rb = Epi::PERM ? ((R & ~31) + perm32(R & 31)) : R;
        voffA[i] = (unsigned)(R * K + C) * 2u; voffB[i] = (unsigned)(Rb * K + C) * 2u; }
    const size_t kstep = (size_t)(BK * 2);
    const size_t hstep = (size_t)HALF * K * 2;
    const size_t tstep = 2 * hstep;
    const unsigned ldsw = (unsigned)wid * 1024u;
    const int aoff = lds_byte(wr * 64 + fr, fq * 8), boff = lds_byte(wc * 32 + fr, fq * 8);
#define PG8_SA(b, h) (((b) * 2 + (h)) * HTB)
#define PG8_SB(b, h) ((4 + (b) * 2 + (h)) * HTB)
#define PG8_STAGE(bufoff, gbase, voff) do { _Pragma("unroll") for (int _i = 0; _i < 2; ++_i) \
        __builtin_amdgcn_global_load_lds((const unsigned*)((const char*)(gbase) + (voff)[_i]), (PG8_LAS unsigned*)(lds + (bufoff) + ldsw + _i * 8192), 16, 0, 0); } while (0)
#define PG8_LDA(dst, b, h) do { _Pragma("unroll") for (int m = 0; m < 4; ++m) _Pragma("unroll") for (int k = 0; k < 2; ++k) dst[m][k] = *(const PG8_LAS bf16x8*)(lds + PG8_SA(b, h) + aoff + m * 2048 + k * 1024); } while (0)
#define PG8_LDB(dst, b, h) do { _Pragma("unroll") for (int n = 0; n < 2; ++n) _Pragma("unroll") for (int k = 0; k < 2; ++k) dst[n][k] = *(const PG8_LAS bf16x8*)(lds + PG8_SB(b, h) + boff + n * 2048 + k * 1024); } while (0)
#define PG8_MMA(ai, bj, At, Bt) do { __builtin_amdgcn_s_setprio(1); _Pragma("unroll") for (int m = 0; m < 4; ++m) _Pragma("unroll") for (int n = 0; n < 2; ++n) _Pragma("unroll") for (int k = 0; k < 2; ++k) \
        acc[ai][bj][m][n] = __builtin_amdgcn_mfma_f32_16x16x32_bf16(Bt[n][k], At[m][k], acc[ai][bj][m][n], 0, 0, 0); __builtin_amdgcn_s_setprio(0); } while (0)
#define PG8_WAIT_V(n) asm volatile("s_waitcnt vmcnt(" #n ")" ::: "memory")
#define PG8_WAIT_L(n) asm volatile("s_waitcnt lgkmcnt(" #n ")" ::: "memory")
#define PG8_BAR __builtin_amdgcn_s_barrier()
#define PG8_SCHED __builtin_amdgcn_sched_barrier(0)
    Unit cur, nxt; int ui = 0;
    if (!S.next(0, cur)) return;
    f32x4 acc[2][2][4][2];
#pragma unroll
    for (int a = 0; a < 2; ++a)
#pragma unroll
        for (int b = 0; b < 2; ++b)
#pragma unroll
            for (int m = 0; m < 4; ++m)
#pragma unroll
                for (int n = 0; n < 2; ++n) acc[a][b][m][n] = (f32x4){0.f, 0.f, 0.f, 0.f};
    bf16x8 At[4][2], B0[2][2], B1[2][2];
    const char* cA = (const char*)g.A + (size_t)cur.pm * tstep; const char* cB = (const char*)g.Bt + (size_t)cur.pn * tstep;
    S.a_ready(cur);
    if constexpr (SP2) {
        PG8_STAGE(PG8_SB(0, 0), cB, voffB); PG8_STAGE(PG8_SB(0, 1), cB + hstep, voffB); PG8_STAGE(PG8_SA(0, 0), cA, voffA); PG8_STAGE(PG8_SA(0, 1), cA + hstep, voffA);
        if (wr == 1) PG8_BAR;
        PG8_WAIT_V(2); PG8_BAR;
        PG8_STAGE(PG8_SB(1, 0), cB + kstep, voffB); PG8_STAGE(PG8_SA(1, 0), cA + kstep, voffA); PG8_STAGE(PG8_SB(1, 1), cB + hstep + kstep, voffB);
        PG8_WAIT_V(6); PG8_BAR;
    } else {
        PG8_STAGE(PG8_SB(0, 0), cB, voffB); PG8_STAGE(PG8_SA(0, 0), cA, voffA); PG8_STAGE(PG8_SB(0, 1), cB + hstep, voffB); PG8_STAGE(PG8_SA(0, 1), cA + hstep, voffA);
        if (wr == 1) PG8_BAR;
        PG8_WAIT_V(4); PG8_BAR;
        PG8_STAGE(PG8_SB(1, 0), cB + kstep, voffB); PG8_STAGE(PG8_SA(1, 0), cA + kstep, voffA); PG8_STAGE(PG8_SB(1, 1), cB + hstep + kstep, voffB);
        PG8_WAIT_V(6); PG8_BAR;
    }
    for (;;) {
        const bool has_next = S.next(ui + 1, nxt);
        const char* nA = has_next ? (const char*)g.A + (size_t)nxt.pm * tstep : cA; const char* nB = has_next ? (const char*)g.Bt + (size_t)nxt.pn * tstep : cB;
        for (int t = 0; t < nt; t += 2) {
            const bool last = (t == nt - 2);
            const char* a1 = cA + (size_t)(t + 1) * kstep;
            const char* a2 = last ? nA : cA + (size_t)(t + 2) * kstep; const char* b2 = last ? nB : cB + (size_t)(t + 2) * kstep;
            const char* a3 = a2 + kstep; const char* b3 = b2 + kstep;
            if (last && has_next) S.a_ready(nxt);
            if constexpr (SP2) {
            PG8_LDB(B0, 0, 0); PG8_LDB(B1, 0, 1); PG8_SCHED; PG8_LDA(At, 0, 0); PG8_STAGE(PG8_SA(1, 1), a1 + hstep, voffA);
            PG8_WAIT_V(8); PG8_WAIT_L(0); PG8_BAR; PG8_MMA(0, 0, At, B0); PG8_MMA(0, 1, At, B1); PG8_BAR; PG8_SCHED;
            PG8_LDA(At, 0, 1); PG8_STAGE(PG8_SB(0, 0), b2, voffB); PG8_STAGE(PG8_SB(0, 1), b2 + hstep, voffB); PG8_STAGE(PG8_SA(0, 0), a2, voffA);
            PG8_WAIT_V(8); PG8_WAIT_L(0); PG8_BAR; PG8_MMA(1, 0, At, B0); PG8_MMA(1, 1, At, B1); PG8_BAR; PG8_SCHED;
            PG8_LDB(B0, 1, 0); PG8_LDB(B1, 1, 1); PG8_SCHED; PG8_LDA(At, 1, 0); PG8_STAGE(PG8_SA(0, 1), a2 + hstep, voffA);
            PG8_WAIT_V(8); PG8_WAIT_L(0); PG8_BAR; PG8_MMA(0, 0, At, B0); PG8_MMA(0, 1, At, B1); PG8_BAR; PG8_SCHED;
            PG8_LDA(At, 1, 1); PG8_STAGE(PG8_SB(1, 0), b3, voffB); PG8_STAGE(PG8_SB(1, 1), b3 + hstep, voffB); PG8_STAGE(PG8_SA(1, 0), a3, voffA);
            PG8_WAIT_V(8); PG8_WAIT_L(0); PG8_BAR; PG8_MMA(1, 0, At, B0); PG8_MMA(1, 1, At, B1); PG8_BAR; PG8_SCHED;
            } else {
            PG8_LDB(B0, 0, 0); PG8_SCHED; PG8_LDA(At, 0, 0); PG8_STAGE(PG8_SA(1, 1), a1 + hstep, voffA);
            PG8_WAIT_L(8); PG8_BAR; PG8_WAIT_L(0); PG8_MMA(0, 0, At, B0); PG8_BAR; PG8_SCHED;
            PG8_LDB(B1, 0, 1); PG8_STAGE(PG8_SB(0, 0), b2, voffB);
            PG8_BAR; PG8_WAIT_L(0); PG8_MMA(0, 1, At, B1); PG8_BAR;
            PG8_LDA(At, 0, 1); PG8_STAGE(PG8_SA(0, 0), a2, voffA);
            PG8_BAR; PG8_WAIT_L(0); PG8_MMA(1, 0, At, B0); PG8_BAR; PG8_SCHED;
            PG8_STAGE(PG8_SB(0, 1), b2 + hstep, voffB);
            PG8_WAIT_V(6); PG8_BAR; PG8_MMA(1, 1, At, B1); PG8_BAR;
            PG8_LDB(B0, 1, 0); PG8_SCHED; PG8_LDA(At, 1, 0); PG8_STAGE(PG8_SA(0, 1), a2 + hstep, voffA);
            PG8_WAIT_L(8); PG8_BAR; PG8_WAIT_L(0); PG8_MMA(0, 0, At, B0); PG8_BAR; PG8_SCHED;
            PG8_LDB(B1, 1, 1); PG8_STAGE(PG8_SB(1, 0), b3, voffB);
            PG8_BAR; PG8_WAIT_L(0); PG8_MMA(0, 1, At, B1); PG8_BAR;
            PG8_LDA(At, 1, 1); PG8_STAGE(PG8_SA(1, 0), a3, voffA);
            PG8_BAR; PG8_WAIT_L(0); PG8_MMA(1, 0, At, B0); PG8_BAR; PG8_SCHED;
            PG8_STAGE(PG8_SB(1, 1), b3 + hstep, voffB);
            PG8_WAIT_V(6); PG8_BAR; PG8_MMA(1, 1, At, B1); PG8_BAR;
            }
        }
        if constexpr (ALIGN_EPI) { if (wr == 0) PG8_BAR; }
        if constexpr (!Epi::AFTER_DRAIN) { E(acc, cur, wr, wc, fr, fq); S.done(cur); }
        if (!has_next) break;
#pragma unroll
        for (int a = 0; a < 2; ++a)
#pragma unroll
            for (int b = 0; b < 2; ++b)
#pragma unroll
                for (int m = 0; m < 4; ++m)
#pragma unroll
                    for (int n = 0; n < 2; ++n) acc[a][b][m][n] = (f32x4){0.f, 0.f, 0.f, 0.f};
        cur = nxt; cA = nA; cB = nB; ++ui;
        if constexpr (ALIGN_EPI) { if (wr == 1) PG8_BAR; }
    }
    PG8_WAIT_V(0);
    if constexpr (!ALIGN_EPI) { if (wr == 0) PG8_BAR; }
    PG8_BAR;
    if constexpr (Epi::AFTER_DRAIN) { E.fused(acc, cur, wr, wc, fr, fq, lds, wid, lane); S.done(cur); }
#undef PG8_SA
#undef PG8_SB
#undef PG8_STAGE
#undef PG8_LDA
#undef PG8_LDB
#undef PG8_MMA
#undef PG8_WAIT_V
#undef PG8_WAIT_L
#undef PG8_BAR
#undef PG8_SCHED
}
}
using namespace pg8;
#define LAS __attribute__((address_space(3)))
typedef float f32x16 __attribute__((ext_vector_type(16)));
typedef short s16x4 __attribute__((ext_vector_type(4)));
typedef __bf16 bf16x2_t __attribute__((ext_vector_type(2)));

#ifndef ONE_LAUNCH
#define ONE_LAUNCH 1
#endif
constexpr int NWAVES = 8, NTHREADS = 512;
constexpr int LDS_BYTES = 147456;
constexpr float LOG2E = 1.4426950408889634f;
constexpr float EPS = 1e-6f;

struct Args { const float* in[26]; float* p_out; unsigned char* p_ws; };

__device__ __forceinline__ float shx(float v, int o, int lane) { return __int_as_float(__builtin_amdgcn_ds_bpermute((lane ^ o) << 2, __float_as_int(v))); }
__device__ __forceinline__ float wave_sum(float v, int lane) {
#pragma unroll
    for (int o = 1; o < 64; o <<= 1) v += shx(v, o, lane);
    return v;
}
__device__ __forceinline__ unsigned f2bf(float f) { unsigned u = __builtin_bit_cast(unsigned, f); return (u + 0x7fffu + ((u >> 16) & 1u)) >> 16; }
__device__ __forceinline__ unsigned pk2(float lo, float hi) { return f2bf(lo) | (f2bf(hi) << 16); }

__device__ __forceinline__ void transpose_item(const float* W, int K, int N, bf16_t* WT, LAS float* scr, int item, int lane) {
    const int nblk = N / 32, kb = item / nblk, nb = item % nblk, k0 = 64 * kb, n0 = 32 * nb;
#pragma unroll
    for (int i = 0; i < 32; ++i) { const int kk = 2 * i + (lane >> 5); scr[kk * 33 + (lane & 31)] = W[(size_t)(k0 + kk) * N + n0 + (lane & 31)]; }
    asm volatile("s_waitcnt lgkmcnt(0)" ::: "memory");
    const int c = lane & 7;
#pragma unroll
    for (int j = 0; j < 4; ++j) { const int n = (lane >> 3) + 8 * j; const LAS float* s = scr + (8 * c) * 33 + n;
        u32x4 o; o.x = pk2(s[0 * 33], s[1 * 33]); o.y = pk2(s[2 * 33], s[3 * 33]); o.z = pk2(s[4 * 33], s[5 * 33]); o.w = pk2(s[6 * 33], s[7 * 33]);
        *(u32x4*)(WT + (size_t)(n0 + n) * K + k0 + 8 * c) = o; }
    asm volatile("s_waitcnt lgkmcnt(0)" ::: "memory");
}

__device__ __forceinline__ void fold_item(const float* wgrp, const float* scale, const float* wpp, bf16_t* WcT, int item, int lane) {
    const int kb = item >> 2, nc = item & 3, k0 = kb * 8, g = k0 >> 7, n0 = nc * 256 + lane * 4;
    f32x4 acc[8];
#pragma unroll
    for (int i = 0; i < 8; ++i) acc[i] = (f32x4){0.f, 0.f, 0.f, 0.f};
#pragma unroll 8
    for (int d = 0; d < 128; ++d) {
        const f32x4 w = *(const f32x4*)(wpp + (size_t)(g * 128 + d) * 1024 + n0) * scale[g * 128 + d];
#pragma unroll
        for (int i = 0; i < 8; ++i) acc[i] += w * wgrp[(size_t)(k0 + i) * 128 + d];
    }
#pragma unroll
    for (int j = 0; j < 4; ++j) { u32x4 o; o.x = pk2(acc[0][j], acc[1][j]); o.y = pk2(acc[2][j], acc[3][j]); o.z = pk2(acc[4][j], acc[5][j]); o.w = pk2(acc[6][j], acc[7][j]);
        *(u32x4*)(WcT + (size_t)(n0 + j) * 512 + k0) = o; }
}

__device__ __forceinline__ void norm_rows_bf16(const float* xp, const float* xs, const float* g, bf16_t* HB, int gw, int ngw, int lane) {
    f32x4 gv[4];
#pragma unroll
    for (int j = 0; j < 4; ++j) gv[j] = ((const f32x4*)g)[lane + 64 * j];
    f32x4 nx[4];
    if (gw < MT) { const f32x4* xr = (const f32x4*)(gw < MP ? xp + (size_t)gw * DM : xs + (size_t)(gw - MP) * DM) + lane;
#pragma unroll
        for (int j = 0; j < 4; ++j) nx[j] = xr[64 * j]; }
    for (int m = gw; m < MT; m += ngw) {
        f32x4 v[4]; float s = 0.f;
#pragma unroll
        for (int j = 0; j < 4; ++j) v[j] = nx[j];
        const int mn = m + ngw;
        if (mn < MT) { const f32x4* xr = (const f32x4*)(mn < MP ? xp + (size_t)mn * DM : xs + (size_t)(mn - MP) * DM) + lane;
#pragma unroll
            for (int j = 0; j < 4; ++j) nx[j] = xr[64 * j]; }
#pragma unroll
        for (int j = 0; j < 4; ++j) s += (v[j].x * v[j].x + v[j].y * v[j].y) + (v[j].z * v[j].z + v[j].w * v[j].w);
        const float r = 1.0f / sqrtf(wave_sum(s, lane) * (1.0f / DM) + EPS);
        unsigned long long* o8 = (unsigned long long*)(HB + (size_t)m * DM) + lane;
#pragma unroll
        for (int j = 0; j < 4; ++j) { const f32x4 y = v[j] * r * gv[j]; o8[64 * j] = (unsigned long long)pk2(y.x, y.y) | ((unsigned long long)pk2(y.z, y.w) << 32); }
    }
}
__device__ __forceinline__ void norm_rows_f32(float* X, const float* g, int gw, int ngw, int lane) {
    f32x4 gv[4];
#pragma unroll
    for (int j = 0; j < 4; ++j) gv[j] = ((const f32x4*)g)[lane + 64 * j];
    for (int m = gw; m < MT; m += ngw) {
        f32x4* xr = (f32x4*)(X + (size_t)m * DM) + lane;
        f32x4 v[4]; float s = 0.f;
#pragma unroll
        for (int j = 0; j < 4; ++j) { v[j] = xr[64 * j]; s += (v[j].x * v[j].x + v[j].y * v[j].y) + (v[j].z * v[j].z + v[j].w * v[j].w); }
        const float r = 1.0f / sqrtf(wave_sum(s, lane) * (1.0f / DM) + EPS);
#pragma unroll
        for (int j = 0; j < 4; ++j) xr[64 * j] = v[j] * r * gv[j];
    }
}

__device__ __forceinline__ bf16x8 pack_p(const f32x16& x, int s) {
    u32x4 p;
#pragma unroll
    for (int j = 0; j < 4; ++j) { f32x2 v = {x[8 * s + 2 * j], x[8 * s + 2 * j + 1]}; bf16x2_t b = __builtin_convertvector(v, bf16x2_t); p[j] = __builtin_bit_cast(unsigned, b); }
    return __builtin_bit_cast(bf16x8, p);
}

template <int NQ>
__device__ __forceinline__ void attn_unit(const bf16_t* Qp, const bf16_t* Kp, const bf16_t* Vtp, int vpitch, int kt0, int kt1, int dq0, const LAS float* tb, bf16_t* Op, int lane) {
    const int r = lane & 31, hi = lane >> 5;
    bf16x8 qf[NQ][4];
#pragma unroll
    for (int qi = 0; qi < NQ; ++qi)
#pragma unroll
        for (int s = 0; s < 4; ++s) qf[qi][s] = *(const bf16x8*)(Qp + (size_t)(32 * qi + r) * 512 + 32 * hi + 8 * s);
    f32x16 o[2][NQ]; float mrun[NQ], lrun[NQ];
#pragma unroll
    for (int qi = 0; qi < NQ; ++qi) { mrun[qi] = -1e30f; lrun[qi] = 0.f;
#pragma unroll
        for (int di = 0; di < 2; ++di)
#pragma unroll
            for (int i = 0; i < 16; ++i) o[di][qi][i] = 0.f; }
    const float bconst = tb[256];
    for (int kt = kt0; kt < kt1; ++kt) {
        const bf16_t* kp = Kp + ((long)(kt * 32 + r)) * 512 + 32 * hi;
        bf16x8 kf[4];
#pragma unroll
        for (int s = 0; s < 4; ++s) kf[s] = *(const bf16x8*)(kp + 8 * s);
        bf16x8 vf[2][2];
#pragma unroll
        for (int di = 0; di < 2; ++di)
#pragma unroll
            for (int ks = 0; ks < 2; ++ks) { const bf16_t* vp = Vtp + (long)(32 * di + r) * vpitch + kt * 32 + 16 * ks + 4 * hi;
                const s16x4 lo = *(const s16x4*)vp, hh = *(const s16x4*)(vp + 8); vf[di][ks] = __builtin_shufflevector(lo, hh, 0, 1, 2, 3, 4, 5, 6, 7); }
#pragma unroll
        for (int qi = 0; qi < NQ; ++qi) {
            f32x16 s;
#pragma unroll
            for (int i = 0; i < 16; ++i) s[i] = 0.f;
#pragma unroll
            for (int st = 0; st < 4; ++st) s = __builtin_amdgcn_mfma_f32_32x32x16_bf16(kf[st], qf[qi][st], s, 0, 0, 0);
            const int dmin = dq0 + 32 * qi - kt * 32 - 31;
            if (dmin >= 128) {
#pragma unroll
                for (int i = 0; i < 16; ++i) s[i] = s[i] * LOG2E + bconst;
            } else {
                const int dbase = dq0 + 32 * qi + r - kt * 32 - 4 * hi;
#pragma unroll
                for (int i = 0; i < 16; ++i) { int dd = dbase - ((i & 3) + 8 * (i >> 2)); dd = dd < -128 ? -128 : (dd > 128 ? 128 : dd); s[i] = s[i] * LOG2E + tb[dd + 128]; }
            }
            float mx = s[0];
#pragma unroll
            for (int i = 1; i < 16; ++i) mx = fmaxf(mx, s[i]);
            mx = fmaxf(mx, shx(mx, 32, lane));
            const float mn = fmaxf(mrun[qi], mx), alpha = __builtin_amdgcn_exp2f(mrun[qi] - mn); mrun[qi] = mn;
            float ps = 0.f;
#pragma unroll
            for (int i = 0; i < 16; ++i) { s[i] = __builtin_amdgcn_exp2f(s[i] - mn); ps += s[i]; }
            lrun[qi] = lrun[qi] * alpha + ps;
#pragma unroll
            for (int di = 0; di < 2; ++di)
#pragma unroll
                for (int i = 0; i < 16; ++i) o[di][qi][i] *= alpha;
#pragma unroll
            for (int ks = 0; ks < 2; ++ks) { const bf16x8 pf = pack_p(s, ks);
#pragma unroll
                for (int di = 0; di < 2; ++di) o[di][qi] = __builtin_amdgcn_mfma_f32_32x32x16_bf16(vf[di][ks], pf, o[di][qi], 0, 0, 0); }
        }
    }
#pragma unroll
    for (int qi = 0; qi < NQ; ++qi) {
        const float lt = lrun[qi] + shx(lrun[qi], 32, lane), inv = 1.0f / lt;
#pragma unroll
        for (int di = 0; di < 2; ++di)
#pragma unroll
            for (int g = 0; g < 4; ++g) {
                const unsigned lo = cvt_pk_bf16(o[di][qi][4 * g] * inv, o[di][qi][4 * g + 1] * inv), hh = cvt_pk_bf16(o[di][qi][4 * g + 2] * inv, o[di][qi][4 * g + 3] * inv);
                *(unsigned long long*)(Op + (size_t)(32 * qi + r) * 512 + 32 * di + 8 * g + 4 * hi) = (unsigned long long)lo | ((unsigned long long)hh << 32);
            }
    }
}

#define XB_TMO      128
#define XB_XCNT(j)  (256  + 64 * (j))
#define XB_XSUB(j)  (1280 + 64 * (j))
#define XB_XGEN(j)  (2304 + 64 * (j))
#define XB_TOP      3328
#define XB_TOPGEN   3392
#define XCD_BAR_WORDS 3456
#define XB_SPIN_CAP (1u << 18)

__device__ __forceinline__ unsigned xb_ld(unsigned* p)              { return __hip_atomic_load(p, __ATOMIC_RELAXED, __HIP_MEMORY_SCOPE_AGENT); }
__device__ __forceinline__ unsigned xb_add(unsigned* p, unsigned v) { return __hip_atomic_fetch_add(p, v, __ATOMIC_RELAXED, __HIP_MEMORY_SCOPE_AGENT); }
__device__ __forceinline__ unsigned xb_xcc_id() { return (unsigned)__builtin_amdgcn_s_getreg((3 << 11) | 20) & 0xFu; }
#define XB_SPIN(cond, bar) do { unsigned _sp = 0; while (cond) { __builtin_amdgcn_s_sleep(1); \
    if ((++_sp & 255u) == 0u) { if (xb_ld(&(bar)[XB_TMO])) break; if (_sp > XB_SPIN_CAP) { atomicAdd(&(bar)[XB_TMO], 1u); break; } } } } while (0)

struct XcdBarrier {
    unsigned* bar; unsigned x;
    volatile LAS unsigned* st;
};

__device__ __forceinline__ XcdBarrier xcd_barrier_post(unsigned* bar, volatile LAS unsigned* st) {
    XcdBarrier b; b.bar = bar; b.x = xb_xcc_id(); b.st = st;
    if (threadIdx.x == 0) (void)xb_add(&bar[XB_XCNT(b.x)], 1u);
    return b;
}
__device__ __forceinline__ void xcd_barrier_complete(unsigned* bar, unsigned x, unsigned& nloc, unsigned& nx) {
    const unsigned G = gridDim.x * gridDim.y * gridDim.z;
    unsigned sum, cnt, mine, sp = 0u;
    for (;;) {
        sum = 0u; cnt = 0u; mine = 0u;
#pragma unroll
        for (unsigned j = 0; j < 16; ++j) { const unsigned c = xb_ld(&bar[XB_XCNT(j)]); sum += c; cnt += (c > 0u) ? 1u : 0u; mine = (j == x) ? c : mine; }
        if (sum == G) break;
        __builtin_amdgcn_s_sleep(1);
        if ((++sp & 255u) == 0u) { if (xb_ld(&bar[XB_TMO])) break; if (sp > XB_SPIN_CAP) { atomicAdd(&bar[XB_TMO], 1u); break; } }
    }
    nloc = mine > 0u ? mine : 1u; nx = cnt > 0u ? cnt : 1u;
}

__device__ __forceinline__ void xcd_barrier(const XcdBarrier& b) {
    asm volatile("s_waitcnt vmcnt(0)" ::: "memory");
    __syncthreads();
    if (threadIdx.x == 0) {
        unsigned* bar = b.bar;
        __builtin_amdgcn_s_waitcnt(0);
        unsigned nloc = b.st[0], nx = b.st[1];
        if (nloc == 0u) { xcd_barrier_complete(bar, b.x, nloc, nx); b.st[0] = nloc; b.st[1] = nx; }
        const unsigned old = xb_add(&bar[XB_XSUB(b.x)], 1u);
        const unsigned gen = old / nloc;
        if (old + 1u == (gen + 1u) * nloc) {
            __builtin_amdgcn_fence(__ATOMIC_RELEASE, "agent");
            asm volatile("s_waitcnt vmcnt(0)" ::: "memory");
            const unsigned og = xb_add(&bar[XB_TOP], 1u);
            const unsigned tg = og / nx;
            if (og + 1u == (tg + 1u) * nx) xb_add(&bar[XB_TOPGEN], 1u);
            else XB_SPIN(xb_ld(&bar[XB_TOPGEN]) == tg, bar);
            __builtin_amdgcn_fence(__ATOMIC_ACQUIRE, "agent");
            xb_add(&bar[XB_XGEN(b.x)], 1u);
            asm volatile("s_waitcnt vmcnt(0)" ::: "memory");
        } else {
            XB_SPIN(xb_ld(&bar[XB_XGEN(b.x)]) == gen, bar);
            __builtin_amdgcn_fence(__ATOMIC_ACQUIRE, "agent");
            asm volatile("s_waitcnt vmcnt(0)" ::: "memory");
        }
    }
    __syncthreads();
}

#define ARGTAB_OFF (131072 + 256)
__device__ __forceinline__ const void* arg_ptr(LAS unsigned char* lds, int i) {
    const unsigned long long v = *(const LAS unsigned long long*)(lds + ARGTAB_OFF + 8 * i);
    const unsigned lo = __builtin_amdgcn_readfirstlane((unsigned)v), hi = __builtin_amdgcn_readfirstlane((unsigned)(v >> 32));
    return (const void*)(((unsigned long long)hi << 32) | lo);
}
#define ARG(i) arg_ptr(lds, (i))
#define GRID_SYNC() do { if (STEP < 0) { XcdBarrier xb_; xb_.bar = (unsigned*)ARG(27); xb_.x = xb_xcc_id(); xb_.st = (volatile LAS unsigned*)(lds + 131072); xcd_barrier(xb_); } } while (0)
#define RUNP(p) (STEP < 0 || STEP == 11 * l + (p) - 1)
#define FRESH_IDS() int tid_ = threadIdx.x; asm volatile("" : "+v"(tid_)); const int tid = tid_, lane = tid & 63, wave = __builtin_amdgcn_readfirstlane(tid >> 6), gw = blockIdx.x * NWAVES + wave, gtid = blockIdx.x * NTHREADS + tid; (void)gw; (void)gtid; (void)lane;
#define x_prompt ((const float*)ARG(0))
#define x_sample ((const float*)ARG(1))
#define cache_pool ((const float*)ARG(2))
#define cache_k ((const float*)ARG(3))
#define cache_v ((const float*)ARG(4))
#define cache_conv ((const float*)ARG(5))
#define p_prompt ((const float*)ARG(6))
#define p_sample ((const float*)ARG(7))
#define g_mix ((const float*)ARG(8))
#define w_in ((const float*)ARG(9))
#define b_gate ((const float*)ARG(10))
#define w_pool_grp ((const float*)ARG(11))
#define pool_scale ((const float*)ARG(12))
#define rel_bias ((const float*)ARG(13))
#define w_pool_proj ((const float*)ARG(14))
#define w_attn_proj ((const float*)ARG(15))
#define w_out ((const float*)ARG(16))
#define g_ffn ((const float*)ARG(17))
#define w_up ((const float*)ARG(18))
#define w_dw ((const float*)ARG(19))
#define b_dw ((const float*)ARG(20))
#define w_down ((const float*)ARG(21))
#define g_ple ((const float*)ARG(22))
#define w_ple ((const float*)ARG(23))
#define w_ple_gate ((const float*)ARG(24))
#define g_final ((const float*)ARG(25))
#define HB ((bf16_t*)(ws + WS_HB))
#define MG RP(R_MG)
#define HB3 RP(R_HB3)
#define RP(off) ((bf16_t*)(ws + WS_R + (off)))
#define Ub RP(R_U)
#define Qb RP(R_Q)
#define Kb RP(R_K)
#define Vtb RP(R_VT)
#define Gb RP(R_G)
#define Db RP(R_D)
#define Ksb RP(R_KS)
#define Vtsb RP(R_VTS)
#define Aup RP(R_A)
#define ACT RP(R_ACT)
#define Pb RP(R_PB)
#define Tb RP(R_T)

template <int MODE> struct SGate {
    bf16_t* O; const bf16_t* G; int goff;
    __device__ __forceinline__ void operator()(int row, int col, float v) const {
        bf16_t* op = O + (size_t)row * 1024 + col;
        if (MODE >= 1) v *= bflo(G[(size_t)row * 2048 + goff + col]);
        if (MODE == 2) v += bflo(*op);
        *op = (bf16_t)(cvt_pk_bf16(v, 0.f) & 0xffffu);
    }
};
struct SRes { const float* base; float* Xo; __device__ __forceinline__ void operator()(int row, int col, float v) const { const size_t o = (size_t)row * DM + col; Xo[o] = base[o] + v; } };
struct SPle { const bf16_t* T; float* Xo; __device__ __forceinline__ void operator()(int row, int col, float v) const { const size_t o = (size_t)row * DM + col; Xo[o] += bflo(T[o]) * sigmoidf_(v); } };
template <class F>
__device__ __forceinline__ void small_gemm(LAS unsigned char* lds, const bf16_t* A, const bf16_t* Bt, int K, const F& f) {
    int tid_ = threadIdx.x; asm volatile("" : "+v"(tid_));
    const int tid = tid_, lane = tid & 63, wave = __builtin_amdgcn_readfirstlane(tid >> 6), r = lane & 31, hi = lane >> 5, kw = K >> 3;
    LAS float* red = (LAS float*)lds;
    for (int tile = blockIdx.x; tile < 256; tile += gridDim.x) {
        const int half = (tile >> 3) & 1, q = (tile & 7) + 8 * (tile >> 4), r0 = MP + (q >> 4) * 32, c0 = (2 * (q & 15) + half) * 32;
        const bf16_t* ap = A + (size_t)(r0 + r) * K + wave * kw + 8 * hi; const bf16_t* bp = Bt + (size_t)(c0 + r) * K + wave * kw + 8 * hi;
        f32x16 acc;
#pragma unroll
        for (int i = 0; i < 16; ++i) acc[i] = 0.f;
#pragma unroll 2
        for (int k = 0; k < kw; k += 16) acc = __builtin_amdgcn_mfma_f32_32x32x16_bf16(*(const bf16x8*)(ap + k), *(const bf16x8*)(bp + k), acc, 0, 0, 0);
#pragma unroll
        for (int i = 0; i < 16; ++i) red[(wave * 16 + i) * 64 + lane] = acc[i];
        __syncthreads();
#pragma unroll
        for (int h = 0; h < 2; ++h) { const int e = tid + 512 * h, i = e >> 6, ln = e & 63; float v = 0.f;
#pragma unroll
            for (int w = 0; w < 8; ++w) v += red[w * 1024 + e];
            f(r0 + (i & 3) + 8 * (i >> 2) + 4 * (ln >> 5), c0 + (ln & 31), v); }
        __syncthreads();
    }
}

__device__ __forceinline__ void convert_weights(LAS unsigned char* lds, int l, int vw, int nvw, int wave, int lane, int it_lo = 0, int it_hi = 1 << 30, bool do_fold = true) {
    LAS float* scr = (LAS float*)(lds + wave * 16384);
    constexpr int I_IN = 16 * 128, I_AP = 8 * 32, I_OUT = 16 * 32, I_UP = 16 * 176, I_DOWN = 44 * 32, I_PLE = 4 * 32, I_PG = 16 * 32;
    constexpr int I_LAYER = I_IN + I_AP + I_OUT + I_UP + I_DOWN + I_PLE + I_PG;
    unsigned char* wl = (unsigned char*)ARG(27) + WS_W + (size_t)l * WL_SIZE;
    const int nfold = (do_fold && nvw > 1024) ? 256 : 0;
    const int it_end = it_hi < I_LAYER ? it_hi : I_LAYER;
    if (vw >= nfold) for (int it = it_lo + vw - nfold; it < it_end; it += nvw - nfold) { int rr = it;
        if (rr < I_IN) { transpose_item(w_in + (size_t)l * 1024 * 4096, 1024, 4096, (bf16_t*)(wl + WL_IN), scr, rr, lane); continue; } rr -= I_IN;
        if (rr < I_AP) { transpose_item(w_attn_proj + (size_t)l * 512 * 1024, 512, 1024, (bf16_t*)(wl + WL_AP), scr, rr, lane); continue; } rr -= I_AP;
        if (rr < I_OUT) { transpose_item(w_out + (size_t)l * 1024 * 1024, 1024, 1024, (bf16_t*)(wl + WL_OUT), scr, rr, lane); continue; } rr -= I_OUT;
        if (rr < I_UP) { transpose_item(w_up + (size_t)l * 1024 * 5632, 1024, 5632, (bf16_t*)(wl + WL_UP), scr, rr, lane); continue; } rr -= I_UP;
        if (rr < I_DOWN) { transpose_item(w_down + (size_t)l * 2816 * 1024, 2816, 1024, (bf16_t*)(wl + WL_DOWN), scr, rr, lane); continue; } rr -= I_DOWN;
        if (rr < I_PLE) { transpose_item(w_ple + (size_t)l * 256 * 1024, 256, 1024, (bf16_t*)(wl + WL_PLE), scr, rr, lane); continue; } rr -= I_PLE;
        transpose_item(w_ple_gate + (size_t)l * 1024 * 1024, 1024, 1024, (bf16_t*)(wl + WL_PG), scr, rr, lane);
    }
    if (do_fold && (vw < nfold || nfold == 0)) for (int it = vw; it < 256; it += (nfold ? nfold : nvw))
        fold_item(w_pool_grp + (size_t)l * 4 * 128 * 128, pool_scale + l * 512, w_pool_proj + (size_t)l * 512 * 1024, (bf16_t*)(wl + WL_C), it, lane);
}

template <int L, int STEP>
__device__ __forceinline__ void layer_body(LAS unsigned char* lds) {
    constexpr int l = L;
    const int G = gridDim.x, ngw = G * NWAVES, ngt = G * NTHREADS;
#define ws ((unsigned char*)ARG(27))
#define out ((float*)ARG(26))
#define X out

#define WLP(off) ((const bf16_t*)(ws + WS_W + (size_t)l * WL_SIZE + (off)))
#define Win_t WLP(WL_IN)
#define Wc_t WLP(WL_C)
#define Wap_t WLP(WL_AP)
#define Wout_t WLP(WL_OUT)
#define Wup_t WLP(WL_UP)
#define Wdown_t WLP(WL_DOWN)
#define Wple_t WLP(WL_PLE)
#define Wpg_t WLP(WL_PG)
        if (RUNP(1))
        {
        FRESH_IDS();
        norm_rows_bf16(l == 0 ? x_prompt : X, l == 0 ? x_sample : X + (size_t)MP * DM, g_mix + l * DM, HB, gw, ngw, lane);
            const float* ck = cache_k + (size_t)l * DBATCH * KCACHE * 512; const float* cv = cache_v + (size_t)l * DBATCH * KCACHE * 512;
            for (int i = gtid; i < DBATCH * KCACHE * 64; i += ngt) { const int b = i >> 15, rem = i & 32767, rw = rem >> 6, c8 = (rem & 63) * 8;
                const float* s = ck + ((size_t)b * KCACHE + rw) * 512 + c8; const f32x4 a = *(const f32x4*)s, bq = *(const f32x4*)(s + 4);
                *(u32x4*)(Ksb + ((size_t)b * KS_ROWS + rw) * 512 + c8) = pack8(a, bq); }
            for (int it = gw; it < DBATCH * 8 * 64; it += ngw) { const int b = it >> 9, h = (it >> 6) & 7, p0 = (it & 63) * 8;
                float v[8];
#pragma unroll
                for (int j = 0; j < 8; ++j) v[j] = cv[((size_t)b * KCACHE + p0 + j) * 512 + h * 64 + lane];
                u32x4 o; o.x = pk2(v[0], v[1]); o.y = pk2(v[2], v[3]); o.z = pk2(v[4], v[5]); o.w = pk2(v[6], v[7]);
                *(u32x4*)(Vtsb + ((size_t)(b * 8 + h) * 64 + lane) * KS_ROWS + p0) = o; }
        }
        GRID_SYNC();
        if (RUNP(2))
        { Gemm g{HB, Win_t, MT, 4096, 1024}; StaticOrder S; S.init(MT, 4096, G, (int)blockIdx.x);
          EpiG1 E{ws, b_gate + l * 2048, l};
          gemm_phase<EpiG1, StaticOrder, true, true>(lds, g, S, E);
          if (l == 0 && STEP < 0) {
              constexpr int nwg = (MT / 256) * 16; int busy = nwg - ((nwg - 1) / G) * G; if (busy >= G) busy = 0;
              if ((int)blockIdx.x >= busy) { FRESH_IDS(); const int vw_ = ((int)blockIdx.x - busy) * NWAVES + wave, nvw_ = (G - busy) * NWAVES;
                  convert_weights(lds, 0, vw_, nvw_, wave, lane, 16 * 128 + 8 * 32 + 16 * 32, 1 << 30, false);
                  convert_weights(lds, 1, vw_, nvw_, wave, lane); } } }
        GRID_SYNC();
        if (RUNP(3))
        {
            FRESH_IDS();
            {
                const float* stg = (const float*)RP(R_STG);
                const size_t so[6] = {S_POOLP, S_KP, S_VP, S_POOLS, S_KS, S_VS}, oo[6] = {O_POOLP, O_KP, O_VP, O_POOLS, O_KS, O_VS}, nn[6] = {S_KP - S_POOLP, S_VP - S_KP, S_POOLS - S_VP, S_KS - S_POOLS, S_VS - S_KS, S_END - S_VS};
#pragma unroll
                for (int k = 0; k < 6; ++k) for (size_t i = (size_t)gtid * 4; i < nn[k]; i += (size_t)ngt * 4) *(f32x4*)(out + oo[k] + (size_t)l * nn[k] + i) = *(const f32x4*)(stg + so[k] + i);
            }
            const float* cp = cache_pool + (size_t)l * DBATCH * 15 * 512;
            for (int i = gtid; i < MT * 64; i += ngt) { const int row = i >> 6, c8 = (i & 63) * 8, w = 2 << (c8 >> 7);
                f32x4 s0 = {0.f, 0.f, 0.f, 0.f}, s1 = s0, u0, u1; float cnt;
                unpack8(*(const u32x4*)(Ub + (size_t)row * 512 + c8), u0, u1);
                if (row < MP) { const int t = row & 2047, n = (t + 1) < w ? (t + 1) : w; cnt = (float)n;
                    s0 = u0; s1 = u1;
#define POOL_TAPS(W) _Pragma("unroll") for (int j = 1; j < (W); ++j) { const bool ok = j <= t; f32x4 a, b; unpack8(*(const u32x4*)(Ub + (size_t)(ok ? row - j : row) * 512 + c8), a, b); const float mk = ok ? 1.f : 0.f; s0 += a * mk; s1 += b * mk; }
                    if (w == 2) { POOL_TAPS(2) } else if (w == 4) { POOL_TAPS(4) } else if (w == 8) { POOL_TAPS(8) } else { POOL_TAPS(16) } }
                else { const int rs = row - MP, b = rs >> 5, t = rs & 31; cnt = (float)w;
                    for (int j = 0; j < w; ++j) { const int tt = t - j; f32x4 a, bq;
                        if (tt >= 0) unpack8(*(const u32x4*)(Ub + (size_t)(row - j) * 512 + c8), a, bq);
                        else { const float* s = cp + ((size_t)b * 15 + 15 + tt) * 512 + c8; a = *(const f32x4*)s; bq = *(const f32x4*)(s + 4); }
                        s0 += a; s1 += bq; } }
                const float ic = 1.0f / cnt;
                *(u32x4*)(Db + (size_t)row * 512 + c8) = pack8(s0 * ic - u0, s1 * ic - u1); }
            LAS float* tball = (LAS float*)lds;
            for (int i = tid; i < 8 * 257; i += NTHREADS) tball[i] = rel_bias[(size_t)l * 8 * 257 + i] * LOG2E;
            __syncthreads();
            for (int ui = gw; ui < 4096 + 64; ui += ngw) {
                const int h = ui & 7; const LAS float* tb = tball + h * 257;
                if (ui < 4096) { const int bc = ui >> 3, b = bc >> 5, c = bc & 31; const long row0 = (long)b * SEQ + c * 64, krow0 = (long)b * SEQ + (long)(c - 8) * 64;
                    attn_unit<2>(Qb + row0 * 512 + h * 64, Kb + krow0 * 512 + h * 64, Vtb + ((long)(b * 8 + h) * 64) * SEQ + (long)(c - 8) * 64, SEQ, c < 8 ? (8 - c) * 2 : 0, 18, 512, tb, Qb + row0 * 512 + h * 64, lane); }
                else { const int b = (ui - 4096) >> 3; const long row0 = (long)MP + b * DSEQ;
                    attn_unit<1>(Qb + row0 * 512 + h * 64, Ksb + (long)b * KS_ROWS * 512 + h * 64, Vtsb + ((long)(b * 8 + h) * 64) * KS_ROWS, KS_ROWS, 0, 17, 512, tb, Qb + row0 * 512 + h * 64, lane); }
            }
        }
        GRID_SYNC();
        if (RUNP(4))
        { StaticOrder S; S.init(MP, 1024, G, (int)blockIdx.x);
          { Gemm g{Db, Wc_t, MP, 1024, 512}; EpiGate<1> E{MG, 1024, Gb, 0}; gemm_phase<EpiGate<1>, StaticOrder, true, true>(lds, g, S, E); }
          { Gemm g{Qb, Wap_t, MP, 1024, 512}; EpiGate<2> E{MG, 1024, Gb, 1024}; gemm_phase<EpiGate<2>, StaticOrder, true, true>(lds, g, S, E); }
          small_gemm(lds, Db, Wc_t, 512, SGate<1>{MG, Gb, 0}); small_gemm(lds, Qb, Wap_t, 512, SGate<2>{MG, Gb, 1024}); }
        GRID_SYNC();
        if (RUNP(5))
        { Gemm g{MG, Wout_t, MP, 1024, 1024}; StaticOrder S; S.init(MP, 1024, G, (int)blockIdx.x);
          EpiRes E{l == 0 ? x_prompt : X, l == 0 ? x_sample : X + (size_t)MP * DM, X}; gemm_phase<EpiRes, StaticOrder, true, true>(lds, g, S, E);
          small_gemm(lds, MG, Wout_t, 1024, SRes{l == 0 ? x_sample - (size_t)MP * DM : X, X}); }
        GRID_SYNC();
        if (RUNP(6))
        { FRESH_IDS(); norm_rows_bf16(X, X + (size_t)MP * DM, g_ffn + l * DM, HB, gw, ngw, lane); }
        GRID_SYNC();
        if (RUNP(7))
        { Gemm g{HB, Wup_t, MT, 2816, 1024}; StaticOrder S; S.init(MT, 2816, G, (int)blockIdx.x);
          EpiUpA E{Aup, (float*)RP(R_STG2), l}; gemm_phase<EpiUpA, StaticOrder, true, true>(lds, g, S, E); }
        GRID_SYNC();
        if (RUNP(8))
        { Gemm g{HB, Wup_t + (size_t)2816 * 1024, MT, 2816, 1024}; StaticOrder S; S.init(MT, 2816, G, (int)blockIdx.x);
          EpiUpB E{Aup, ACT, w_dw + (size_t)l * 3 * DFF, b_dw + (size_t)l * DFF, cache_conv + (size_t)l * DBATCH * 2 * DFF}; gemm_phase<EpiUpB, StaticOrder, true, true>(lds, g, S, E); }
        GRID_SYNC();
        if (RUNP(9))
        { Gemm g{ACT, Wdown_t, MP, 1024, 2816}; StaticOrder S; S.init(MP, 1024, G, (int)blockIdx.x);
          EpiRes E{X, X + (size_t)MP * DM, X}; gemm_phase<EpiRes, StaticOrder, true, true>(lds, g, S, E);
          small_gemm(lds, ACT, Wdown_t, 2816, SRes{X, X}); }
        GRID_SYNC();
        if (RUNP(10))
        { FRESH_IDS(); norm_rows_bf16(X, X + (size_t)MP * DM, g_ple + l * DM, HB3, gw, ngw, lane);
          { const float* stg = (const float*)RP(R_STG2);
            for (size_t i = (size_t)gtid * 4; i < S_CONVS; i += (size_t)ngt * 4) *(f32x4*)(out + O_CONVP + (size_t)l * S_CONVS + i) = *(const f32x4*)(stg + S_CONVP + i);
            for (size_t i = (size_t)gtid * 4; i < S_CEND - S_CONVS; i += (size_t)ngt * 4) *(f32x4*)(out + O_CONVS + (size_t)l * (S_CEND - S_CONVS) + i) = *(const f32x4*)(stg + S_CONVS + i); }
          const float* pp = p_prompt + (size_t)l * MP * 256; const float* ps = p_sample + (size_t)l * MS * 256;
          for (int i = gtid; i < MT * 32; i += ngt) { const size_t e = (size_t)i * 8; const float* s = e < (size_t)MP * 256 ? pp + e : ps + (e - (size_t)MP * 256);
              const f32x4 a = *(const f32x4*)s, b = *(const f32x4*)(s + 4); *(u32x4*)(Pb + e) = pack8(a, b); } }
        GRID_SYNC();
        if (RUNP(11))
        { StaticOrder S; S.init(MP, 1024, G, (int)blockIdx.x);
          { Gemm g{Pb, Wple_t, MP, 1024, 256}; EpiGate<0> E{Tb, 1024, nullptr, 0}; gemm_phase<EpiGate<0>, StaticOrder, true, true>(lds, g, S, E); }
          { Gemm g{HB3, Wpg_t, MP, 1024, 1024}; EpiPle E{Tb, X}; gemm_phase<EpiPle, StaticOrder, true, true>(lds, g, S, E); }
          small_gemm(lds, Pb, Wple_t, 256, SGate<0>{Tb, nullptr, 0}); small_gemm(lds, HB3, Wpg_t, 1024, SPle{Tb, X}); }
        GRID_SYNC();

}

template <int STEP>
__global__ void __launch_bounds__(NTHREADS, 2) mega_fwd(Args args) {
    extern __shared__ __attribute__((aligned(16))) unsigned char lds_raw[];
    LAS unsigned char* lds = (LAS unsigned char*)lds_raw;
    cg::grid_group grid = cg::this_grid();
    const int G = gridDim.x, ngw = G * NWAVES, ngt = G * NTHREADS;
    for (int u = threadIdx.x; u < 64; u += NTHREADS) ((LAS unsigned*)(lds + 131072))[u] = 0u;
    __syncthreads();
    if (threadIdx.x == 0) { LAS unsigned long long* tab = (LAS unsigned long long*)(lds + ARGTAB_OFF);
        tab[0] = (unsigned long long)args.in[0];
        tab[1] = (unsigned long long)args.in[1];
        tab[2] = (unsigned long long)args.in[2];
        tab[3] = (unsigned long long)args.in[3];
        tab[4] = (unsigned long long)args.in[4];
        tab[5] = (unsigned long long)args.in[5];
        tab[6] = (unsigned long long)args.in[6];
        tab[7] = (unsigned long long)args.in[7];
        tab[8] = (unsigned long long)args.in[8];
        tab[9] = (unsigned long long)args.in[9];
        tab[10] = (unsigned long long)args.in[10];
        tab[11] = (unsigned long long)args.in[11];
        tab[12] = (unsigned long long)args.in[12];
        tab[13] = (unsigned long long)args.in[13];
        tab[14] = (unsigned long long)args.in[14];
        tab[15] = (unsigned long long)args.in[15];
        tab[16] = (unsigned long long)args.in[16];
        tab[17] = (unsigned long long)args.in[17];
        tab[18] = (unsigned long long)args.in[18];
        tab[19] = (unsigned long long)args.in[19];
        tab[20] = (unsigned long long)args.in[20];
        tab[21] = (unsigned long long)args.in[21];
        tab[22] = (unsigned long long)args.in[22];
        tab[23] = (unsigned long long)args.in[23];
        tab[24] = (unsigned long long)args.in[24];
        tab[25] = (unsigned long long)args.in[25];
        tab[26] = (unsigned long long)args.p_out; tab[27] = (unsigned long long)args.p_ws; }
    __syncthreads();
    if (STEP < 0) { (void)xcd_barrier_post((unsigned*)ARG(27), (volatile LAS unsigned*)(lds + 131072)); grid.sync(); }
    if (STEP < 0 || STEP == 0) {
        FRESH_IDS();
        constexpr int I_EARLY = 16 * 128 + 8 * 32 + 16 * 32;
        convert_weights(lds, 0, gw, ngw, wave, lane, 0, STEP < 0 ? I_EARLY : (1 << 30));
        if (STEP >= 0) convert_weights(lds, 1, gw, ngw, wave, lane);
    }

    layer_body<0, STEP>(lds);
    layer_body<1, STEP>(lds);
    if (STEP < 0 || STEP == 22)
    { FRESH_IDS(); norm_rows_f32(X, g_final, gw, ngw, lane); }
}

#undef ws
#undef out
#undef X
extern "C" void kernel_launch(void* const* d_in, const int* in_sizes, int n_in, void* d_out, int out_size, void* d_ws, size_t ws_size, hipStream_t stream) {
    static int grid = 0;
    if (grid == 0) {
        if (n_in != 26 || (size_t)out_size != O_END || ws_size < WS_END) { fprintf(stderr, "kernel_launch: unexpected shapes: n_in %d out %d ws %zu (need %zu)\n", n_in, out_size, ws_size, (size_t)WS_END); grid = -1; return; }
        int dev = 0, cus = 0, per_cu = 0;
        hipGetDevice(&dev); hipDeviceGetAttribute(&cus, hipDeviceAttributeMultiprocessorCount, dev);
        if (hipFuncSetAttribute((const void*)mega_fwd<-1>, hipFuncAttributeMaxDynamicSharedMemorySize, LDS_BYTES) != hipSuccess) { fprintf(stderr, "kernel_launch: hipFuncSetAttribute failed\n"); grid = -1; return; }
        if (hipOccupancyMaxActiveBlocksPerMultiprocessor(&per_cu, (const void*)mega_fwd<-1>, NTHREADS, LDS_BYTES) != hipSuccess || per_cu < 1) { fprintf(stderr, "kernel_launch: occupancy query gives %d\n", per_cu); grid = -1; (void)hipGetLastError(); return; }
        grid = cus;
#if !ONE_LAUNCH
        { typedef void (*kfn)(Args);
          const kfn fa[23] = {mega_fwd<0>, mega_fwd<1>, mega_fwd<2>, mega_fwd<3>, mega_fwd<4>, mega_fwd<5>, mega_fwd<6>, mega_fwd<7>, mega_fwd<8>, mega_fwd<9>, mega_fwd<10>, mega_fwd<11>,
                              mega_fwd<12>, mega_fwd<13>, mega_fwd<14>, mega_fwd<15>, mega_fwd<16>, mega_fwd<17>, mega_fwd<18>, mega_fwd<19>, mega_fwd<20>, mega_fwd<21>, mega_fwd<22>};
          for (int i = 0; i < 23; ++i) if (hipFuncSetAttribute((const void*)fa[i], hipFuncAttributeMaxDynamicSharedMemorySize, LDS_BYTES) != hipSuccess) { fprintf(stderr, "kernel_launch: hipFuncSetAttribute failed for step %d\n", i); grid = -1; return; } }
#endif
    }
    if (grid < 0) return;
    if (hipMemsetAsync(d_ws, 0, 65536, stream) != hipSuccess) { fprintf(stderr, "memset failed\n"); return; }
    Args a{};
    for (int i = 0; i < 26; ++i) a.in[i] = (const float*)d_in[i];
    a.p_out = (float*)d_out; a.p_ws = (unsigned char*)d_ws;
    void* kargs[] = {&a};
#if ONE_LAUNCH
    hipError_t e = hipLaunchCooperativeKernel((const void*)mega_fwd<-1>, dim3(grid), dim3(NTHREADS), kargs, LDS_BYTES, stream);
    if (e != hipSuccess) fprintf(stderr, "cooperative launch failed: %s (grid %d)\n", hipGetErrorString(e), grid);
#else
    typedef void (*kfn)(Args);
    static const kfn fns[23] = {mega_fwd<0>, mega_fwd<1>, mega_fwd<2>, mega_fwd<3>, mega_fwd<4>, mega_fwd<5>, mega_fwd<6>, mega_fwd<7>, mega_fwd<8>, mega_fwd<9>, mega_fwd<10>, mega_fwd<11>,
                                mega_fwd<12>, mega_fwd<13>, mega_fwd<14>, mega_fwd<15>, mega_fwd<16>, mega_fwd<17>, mega_fwd<18>, mega_fwd<19>, mega_fwd<20>, mega_fwd<21>, mega_fwd<22>};
    for (int st = 0; st < 23; ++st) hipLaunchKernelGGL(fns[st], dim3(grid), dim3(NTHREADS), LDS_BYTES, stream, a);
#endif
}
```

```cpp
#include <hip/hip_runtime.h>
#include <hip/hip_cooperative_groups.h>
#include <cstdio>
#include <cstdint>
namespace cg = cooperative_groups;
namespace pg8 {
#define PG8_LAS __attribute__((address_space(3)))
typedef unsigned short bf16_t;
typedef short bf16x8 __attribute__((ext_vector_type(8)));
typedef float f32x4 __attribute__((ext_vector_type(4)));
typedef unsigned u32x4 __attribute__((ext_vector_type(4)));
constexpr int BM = 256, BK = 64, HALF = 128, HTB = HALF * BK * 2  , STAGE_BYTES = 8 * HTB, NXCD = 8, WGM = 8;

__host__ __device__ __forceinline__ int lds_byte(int r, int c) { const int st = (r >> 4) * 2 + (c >> 5), rr = r & 15, cc = c & 31, ob = rr * 64 + cc * 2; return st * 1024 + (ob ^ (((ob >> 9) & 1) << 5)); }
__host__ __device__ __forceinline__ void stage_rc(int b, int& R, int& C) { const int st = b / 1024, sb = b % 1024, swz = sb ^ (((sb >> 9) & 1) << 5); R = (st >> 1) * 16 + swz / 64; C = (st & 1) * 32 + (swz % 64) / 2; }
__host__ __device__ __forceinline__ int perm32(int rho) { const int n = rho >> 4, i = rho & 15; return 8 * (i >> 2) + 4 * n + (i & 3); }

struct Unit { int pm, pn; };
struct Gemm { const bf16_t* A; const bf16_t* Bt; int M, N, K; };

struct StaticOrder {
    int nM, nN, nwg, G, c;
    __host__ __device__ void init(int M, int N, int G_, int c_) { nM = M / BM; nN = N / BM; nwg = nM * nN; G = G_; c = c_; }
    __host__ __device__ bool next(int i, Unit& u) const {
        const long L = (long)i * G + c; if (L >= nwg) return false;
        int wgid = (int)L; { const int q = nwg / NXCD, r = nwg % NXCD, xcd = wgid % NXCD, off = wgid / NXCD; wgid = (xcd < r ? xcd * (q + 1) : r * (q + 1) + (xcd - r) * q) + off; }
        const int nig = WGM * nN, gid = wgid / nig, fm = gid * WGM, gsz = (nM - fm) < WGM ? (nM - fm) : WGM;
        u.pm = fm + ((wgid % nig) % gsz); u.pn = (wgid % nig) / gsz; return true;
    }
    __device__ __forceinline__ void a_ready(const Unit&) const {}
    __device__ __forceinline__ void done(const Unit&) const {}
};


constexpr int DM = 1024, NBATCH = 16, SEQ = 2048, DBATCH = 8, DSEQ = 32;
constexpr int MP = NBATCH * SEQ, MS = DBATCH * DSEQ, MT = MP + MS;
constexpr int DFF = 2816, KCACHE = 512, KS_ROWS = KCACHE + DSEQ;
constexpr size_t O_YP = 0, O_YS = (size_t)MP * DM, O_POOLP = O_YS + (size_t)MS * DM, O_KP = O_POOLP + 2 * 16 * 15 * 512,
                 O_VP = O_KP + (size_t)2 * 16 * 512 * 512, O_CONVP = O_VP + (size_t)2 * 16 * 512 * 512, O_POOLS = O_CONVP + 2 * 16 * 2 * 2816,
                 O_KS = O_POOLS + 2 * 8 * 15 * 512, O_VS = O_KS + 2 * 8 * 32 * 512, O_CONVS = O_VS + 2 * 8 * 32 * 512, O_END = O_CONVS + 2 * 8 * 2 * 2816;

constexpr size_t MiB = 1u << 20;
constexpr size_t WL_IN = 0, WL_C = 8 * MiB, WL_AP = 9 * MiB, WL_OUT = 10 * MiB, WL_UP = 12 * MiB, WL_DOWN = 23 * MiB, WL_PLE = 29 * MiB  , WL_PG = 30 * MiB, WL_SIZE = 32 * MiB;
static_assert(WL_DOWN + (size_t)1024 * 2816 * 2 <= WL_PLE && WL_UP + (size_t)5632 * 1024 * 2 <= WL_DOWN, "weights map");
constexpr size_t WS_W = 1 * MiB;
constexpr size_t WS_HB = WS_W + 2 * WL_SIZE;
constexpr size_t WS_R = WS_HB + 65 * MiB;
constexpr size_t R_U = 0, R_Q = 33 * MiB, R_K = 66 * MiB, R_VT = 99 * MiB, R_G = 131 * MiB, R_D = 260 * MiB, R_KS = 293 * MiB, R_VTS = 298 * MiB;
constexpr size_t R_A = 0, R_ACT = 178 * MiB;
constexpr size_t R_PB = 0, R_T = 17 * MiB, R_HB3 = 82 * MiB;
constexpr size_t R_STG = 303 * MiB, R_STG2 = 357 * MiB;
constexpr size_t R_MG = 303 * MiB;
constexpr size_t WS_END = WS_R + 368 * MiB;
static_assert((size_t)MT * 2816 * 2 <= 178 * MiB && (size_t)MT * 2048 * 2 <= 129 * MiB && (size_t)MT * 512 * 2 <= 33 * MiB && (size_t)MT * 1024 * 2 <= 65 * MiB, "ws map");
static_assert(WS_END <= 512 * MiB, "ws budget");

constexpr size_t S_POOLP = 0, S_KP = 16 * 15 * 512, S_VP = S_KP + (size_t)16 * 512 * 512, S_POOLS = S_VP + (size_t)16 * 512 * 512, S_KS = S_POOLS + 8 * 15 * 512, S_VS = S_KS + 8 * 32 * 512, S_END = S_VS + 8 * 32 * 512;
constexpr size_t S_CONVP = 0, S_CONVS = 16 * 2 * 2816, S_CEND = S_CONVS + 8 * 2 * 2816;
typedef float f32x2 __attribute__((ext_vector_type(2)));
__device__ __forceinline__ unsigned cvt_pk_bf16(float lo, float hi) { unsigned r; asm volatile("v_cvt_pk_bf16_f32 %0, %1, %2" : "=v"(r) : "v"(lo), "v"(hi)); return r; }
__device__ __forceinline__ float bflo(unsigned u) { return __uint_as_float(u << 16); }
__device__ __forceinline__ float bfhi(unsigned u) { return __uint_as_float(u & 0xffff0000u); }
__device__ __forceinline__ float sigmoidf_(float x) { return __builtin_amdgcn_rcpf(1.0f + __builtin_amdgcn_exp2f(-1.4426950408889634f * x)); }
__device__ __forceinline__ float gelu_tanh(float x) { const float u = 1.5957691216057308f * x * (1.0f + 0.044715f * x * x); return x * sigmoidf_(u); }
__device__ __forceinline__ u32x4 pack8(const f32x4 a, const f32x4 b) { u32x4 w; w.x = cvt_pk_bf16(a[0], a[1]); w.y = cvt_pk_bf16(a[2], a[3]); w.z = cvt_pk_bf16(b[0], b[1]); w.w = cvt_pk_bf16(b[2], b[3]); return w; }
__device__ __forceinline__ void unpack8(const u32x4 w, f32x4& a, f32x4& b) { a = (f32x4){bflo(w.x), bfhi(w.x), bflo(w.y), bfhi(w.y)}; b = (f32x4){bflo(w.z), bfhi(w.z), bflo(w.w), bfhi(w.w)}; }

#define EPI_LOOP_BEGIN asm volatile("" : "+v"(fr), "+v"(fq));     \
    _Pragma("unroll") for (int ai = 0; ai < 2; ++ai) _Pragma("unroll") for (int m = 0; m < 4; ++m) { const int row = u.pm * BM + ai * HALF + wr * 64 + m * 16 + fr; \
    _Pragma("unroll") for (int bj = 0; bj < 2; ++bj) { const int c = u.pn * BM + bj * HALF + wc * 32 + 8 * fq; f32x4 v0 = acc[ai][bj][m][0], v1 = acc[ai][bj][m][1];
#define EPI_LOOP_END } asm volatile("" ::: "memory"); }

struct EpiG1 {
    static constexpr bool PERM = true, AFTER_DRAIN = false;
    unsigned char* wsb; const float* bgate; int layer; float* dout;
    __device__ __forceinline__ void operator()(const f32x4 (&acc)[2][2][4][2], const Unit& u, int wr, int wc, int fr, int fq) const {
        const int kind = u.pn < 8 ? (u.pn >> 1) : 4; const bool samp = u.pm >= MP / BM;
        unsigned char* wsb = this->wsb; asm volatile("" : "+s"(wsb));
        bf16_t* const U = (bf16_t*)(wsb + WS_R + R_U); bf16_t* const Q = (bf16_t*)(wsb + WS_R + R_Q); bf16_t* const Kp = (bf16_t*)(wsb + WS_R + R_K); bf16_t* const Vtp = (bf16_t*)(wsb + WS_R + R_VT);
        bf16_t* const Ks = (bf16_t*)(wsb + WS_R + R_KS); bf16_t* const Vts = (bf16_t*)(wsb + WS_R + R_VTS); bf16_t* const G = (bf16_t*)(wsb + WS_R + R_G);
        EPI_LOOP_BEGIN
            int b, t; if (samp) { const int rs = row - MP; b = rs >> 5; t = rs & 31; } else { b = row >> 11; t = row & 2047; }
            if (kind == 0) {
                *(u32x4*)(U + (size_t)row * 512 + c) = pack8(v0, v1);
                if (!samp) { if (t >= SEQ - 15) { float* o = dout + O_POOLP + (size_t)layer * (16 * 15 * 512) + ((size_t)b * 15 + (t - (SEQ - 15))) * 512 + c; *(f32x4*)o = v0; *(f32x4*)(o + 4) = v1; } }
                else { if (t >= DSEQ - 15) { float* o = dout + O_POOLS + (size_t)layer * (8 * 15 * 512) + ((size_t)b * 15 + (t - (DSEQ - 15))) * 512 + c; *(f32x4*)o = v0; *(f32x4*)(o + 4) = v1; } }
            } else if (kind == 1) {
                *(u32x4*)(Q + (size_t)row * 512 + (c - 512)) = pack8(v0 * 0.125f, v1 * 0.125f);
            } else if (kind == 2) {
                const int ck = c - 1024;
                if (!samp) { *(u32x4*)(Kp + (size_t)row * 512 + ck) = pack8(v0, v1);
                    if (t >= SEQ - 512) { float* o = dout + O_KP + (size_t)layer * (16 * 512 * 512) + ((size_t)b * 512 + (t - (SEQ - 512))) * 512 + ck; *(f32x4*)o = v0; *(f32x4*)(o + 4) = v1; } }
                else { *(u32x4*)(Ks + ((size_t)b * KS_ROWS + KCACHE + t) * 512 + ck) = pack8(v0, v1);
                    float* o = dout + O_KS + (size_t)layer * (8 * 32 * 512) + ((size_t)b * 32 + t) * 512 + ck; *(f32x4*)o = v0; *(f32x4*)(o + 4) = v1; }
            } else if (kind == 3) {
                const int cv = c - 1536, h = cv >> 6, d0 = cv & 63; const u32x4 w = pack8(v0, v1);
                bf16_t* vb; size_t pitch;
                if (!samp) { vb = Vtp + ((size_t)(b * 8 + h) * 64 + d0) * SEQ + t; pitch = SEQ;
                    if (t >= SEQ - 512) { float* o = dout + O_VP + (size_t)layer * (16 * 512 * 512) + ((size_t)b * 512 + (t - (SEQ - 512))) * 512 + cv; *(f32x4*)o = v0; *(f32x4*)(o + 4) = v1; } }
                else { vb = Vts + ((size_t)(b * 8 + h) * 64 + d0) * KS_ROWS + KCACHE + t; pitch = KS_ROWS;
                    float* o = dout + O_VS + (size_t)layer * (8 * 32 * 512) + ((size_t)b * 32 + t) * 512 + cv; *(f32x4*)o = v0; *(f32x4*)(o + 4) = v1; }
                vb[0 * pitch] = (bf16_t)(w.x & 0xffffu); vb[1 * pitch] = (bf16_t)(w.x >> 16); vb[2 * pitch] = (bf16_t)(w.y & 0xffffu); vb[3 * pitch] = (bf16_t)(w.y >> 16);
                vb[4 * pitch] = (bf16_t)(w.z & 0xffffu); vb[5 * pitch] = (bf16_t)(w.z >> 16); vb[6 * pitch] = (bf16_t)(w.w & 0xffffu); vb[7 * pitch] = (bf16_t)(w.w >> 16);
            } else {
                const int cgt = c - 2048; const f32x4 b0 = *(const f32x4*)(bgate + cgt), b1 = *(const f32x4*)(bgate + cgt + 4);
                v0 = v0 + b0; v1 = v1 + b1;
                _Pragma("unroll") for (int j = 0; j < 4; ++j) { v0[j] = sigmoidf_(v0[j]); v1[j] = sigmoidf_(v1[j]); }
                *(u32x4*)(G + (size_t)row * 2048 + cgt) = pack8(v0, v1);
            }
        EPI_LOOP_END
    }
};
template <int MODE> struct EpiGate {
    static constexpr bool PERM = true, AFTER_DRAIN = false;
    bf16_t* O; int ldc; const bf16_t* G; int goff;
    __device__ __forceinline__ void operator()(const f32x4 (&acc)[2][2][4][2], const Unit& u, int wr, int wc, int fr, int fq) const {
        EPI_LOOP_BEGIN
            bf16_t* op = O + (size_t)row * ldc + c;
            if (MODE >= 1) { f32x4 g0, g1; unpack8(*(const u32x4*)(G + (size_t)row * 2048 + goff + c), g0, g1); v0 = v0 * g0; v1 = v1 * g1; }
            if (MODE == 2) { f32x4 p0, p1; unpack8(*(const u32x4*)op, p0, p1); v0 = v0 + p0; v1 = v1 + p1; }
            *(u32x4*)op = pack8(v0, v1);
        EPI_LOOP_END
    }
};
struct EpiRes {
    static constexpr bool PERM = true, AFTER_DRAIN = false;
    const float* bp; const float* bs; float* X;
    __device__ __forceinline__ void operator()(const f32x4 (&acc)[2][2][4][2], const Unit& u, int wr, int wc, int fr, int fq) const {
        const float* base = u.pm >= MP / BM ? bs - (size_t)MP * DM : bp;
        asm volatile("" : "+v"(fr), "+v"(fq));
        const size_t off0 = (size_t)(u.pm * BM + wr * 64 + fr) * DM + u.pn * BM + wc * 32 + 8 * fq;
        f32x4 cur[2][2], nxt[2][2];
#pragma unroll
        for (int bj = 0; bj < 2; ++bj) { cur[bj][0] = *(const f32x4*)(base + off0 + bj * HALF); cur[bj][1] = *(const f32x4*)(base + off0 + bj * HALF + 4); }
#pragma unroll
        for (int it = 0; it < 8; ++it) { const int ai = it >> 2, m = it & 3; const size_t off = off0 + (size_t)(ai * HALF + m * 16) * DM;
            if (it < 7) { const size_t offn = off0 + (size_t)(((it + 1) >> 2) * HALF + ((it + 1) & 3) * 16) * DM;
#pragma unroll
                for (int bj = 0; bj < 2; ++bj) { nxt[bj][0] = *(const f32x4*)(base + offn + bj * HALF); nxt[bj][1] = *(const f32x4*)(base + offn + bj * HALF + 4); } }
#pragma unroll
            for (int bj = 0; bj < 2; ++bj) { *(f32x4*)(X + off + bj * HALF) = cur[bj][0] + acc[ai][bj][m][0]; *(f32x4*)(X + off + bj * HALF + 4) = cur[bj][1] + acc[ai][bj][m][1]; }
#pragma unroll
            for (int bj = 0; bj < 2; ++bj) { cur[bj][0] = nxt[bj][0]; cur[bj][1] = nxt[bj][1]; }
            asm volatile("" ::: "memory"); }
    }
};
struct EpiPle {
    static constexpr bool PERM = true, AFTER_DRAIN = false;
    const bf16_t* T; float* X;
    __device__ __forceinline__ void operator()(const f32x4 (&acc)[2][2][4][2], const Unit& u, int wr, int wc, int fr, int fq) const {
        EPI_LOOP_BEGIN
            const size_t off = (size_t)row * DM + c; f32x4 t0, t1; unpack8(*(const u32x4*)(T + off), t0, t1);
            f32x4 x0 = *(const f32x4*)(X + off), x1 = *(const f32x4*)(X + off + 4);
            _Pragma("unroll") for (int j = 0; j < 4; ++j) { x0[j] += t0[j] * sigmoidf_(v0[j]); x1[j] += t1[j] * sigmoidf_(v1[j]); }
            *(f32x4*)(X + off) = x0; *(f32x4*)(X + off + 4) = x1;
        EPI_LOOP_END
    }
};
struct EpiUpA {
    static constexpr bool PERM = true, AFTER_DRAIN = false;
    bf16_t* A; float* out; int layer;
    __device__ __forceinline__ void operator()(const f32x4 (&acc)[2][2][4][2], const Unit& u, int wr, int wc, int fr, int fq) const {
        const bool samp = u.pm >= MP / BM;
        EPI_LOOP_BEGIN
            *(u32x4*)(A + (size_t)row * DFF + c) = pack8(v0, v1);
            if (!samp) { const int b = row >> 11, t = row & 2047; if (t >= SEQ - 2) { float* o = out + O_CONVP + (size_t)layer * (16 * 2 * 2816) + ((size_t)b * 2 + (t - (SEQ - 2))) * DFF + c; *(f32x4*)o = v0; *(f32x4*)(o + 4) = v1; } }
            else { const int rs = row - MP, b = rs >> 5, t = rs & 31; if (t >= DSEQ - 2) { float* o = out + O_CONVS + (size_t)layer * (8 * 2 * 2816) + ((size_t)b * 2 + (t - (DSEQ - 2))) * DFF + c; *(f32x4*)o = v0; *(f32x4*)(o + 4) = v1; } }
        EPI_LOOP_END
    }
};
struct EpiUpB {
    static constexpr bool PERM = true, AFTER_DRAIN = false;
    const bf16_t* A; bf16_t* ACT; const float* wdw; const float* bdw; const float* cconv;
    __device__ __forceinline__ void operator()(const f32x4 (&acc)[2][2][4][2], const Unit& u, int wr, int wc, int fr, int fq) const {
        const bool samp = u.pm >= MP / BM;
        EPI_LOOP_BEGIN
            int b, t; if (samp) { const int rs = row - MP; b = rs >> 5; t = rs & 31; } else { b = row >> 11; t = row & 2047; }
            const bf16_t* ap = A + (size_t)row * DFF + c;
            f32x4 a00, a01, a10, a11, a20, a21;
            unpack8(*(const u32x4*)ap, a00, a01);
            if (t >= 1) unpack8(*(const u32x4*)(ap - DFF), a10, a11);
            else if (samp) { const float* cp = cconv + ((size_t)b * 2 + 1) * DFF + c; a10 = *(const f32x4*)cp; a11 = *(const f32x4*)(cp + 4); }
            else { a10 = (f32x4){0.f, 0.f, 0.f, 0.f}; a11 = a10; }
            if (t >= 2) unpack8(*(const u32x4*)(ap - 2 * DFF), a20, a21);
            else if (samp) { const float* cp = cconv + ((size_t)b * 2 + t) * DFF + c; a20 = *(const f32x4*)cp; a21 = *(const f32x4*)(cp + 4); }
            else { a20 = (f32x4){0.f, 0.f, 0.f, 0.f}; a21 = a20; }
            const f32x4 w00 = *(const f32x4*)(wdw + c), w01 = *(const f32x4*)(wdw + c + 4), w10 = *(const f32x4*)(wdw + DFF + c), w11 = *(const f32x4*)(wdw + DFF + c + 4),
                        w20 = *(const f32x4*)(wdw + 2 * DFF + c), w21 = *(const f32x4*)(wdw + 2 * DFF + c + 4), bb0 = *(const f32x4*)(bdw + c), bb1 = *(const f32x4*)(bdw + c + 4);
            f32x4 s0 = bb0 + w00 * a20 + w10 * a10 + w20 * a00, s1 = bb1 + w01 * a21 + w11 * a11 + w21 * a01;
            _Pragma("unroll") for (int j = 0; j < 4; ++j) { s0[j] = gelu_tanh(s0[j]) * v0[j]; s1[j] = gelu_tanh(s1[j]) * v1[j]; }
            *(u32x4*)(ACT + (size_t)row * DFF + c) = pack8(s0, s1);
        EPI_LOOP_END
    }
};

template <class Epi, class Sched, bool ALIGN_EPI = false, bool SP2 = false>
__device__ __forceinline__ void gemm_phase(PG8_LAS unsigned char* lds, const Gemm g, const Sched& S, const Epi& E) {
    int tid_ = threadIdx.x; asm volatile("" : "+v"(tid_));
    const int tid = tid_, wid = __builtin_amdgcn_readfirstlane(tid >> 6), lane = tid & 63, wr = wid >> 2, wc = wid & 3, fr = lane & 15, fq = lane >> 4;
    int K_ = g.K; if (g.K < 512) asm volatile("" : "+s"(K_));
    const int K = K_, nt = K / BK;
    unsigned voffA[2], voffB[2];
#pragma unroll
    for (int i = 0; i < 2; ++i) { int R, C; stage_rc(tid * 16 + i * 8192, R, C); const int Rb = Epi::PERM ? ((R & ~31) + perm32(R & 31)) : R;
        voffA[i] = (unsigned)(R * K + C) * 2u; voffB[i] = (unsigned)(Rb * K + C) * 2u; }
    const size_t kstep = (size_t)(BK * 2);
    const size_t hstep = (size_t)HALF * K * 2;
    const size_t tstep = 2 * hstep;
    const unsigned ldsw = (unsigned)wid * 1024u;
    const int aoff = lds_byte(wr * 64 + fr, fq * 8), boff = lds_byte(wc * 32 + fr, fq * 8);
#define PG8_SA(b, h) (((b) * 2 + (h)) * HTB)
#define PG8_SB(b, h) ((4 + (b) * 2 + (h)) * HTB)
#define PG8_STAGE(bufoff, gbase, voff) do { _Pragma("unroll") for (int _i = 0; _i < 2; ++_i) \
        __builtin_amdgcn_global_load_lds((const unsigned*)((const char*)(gbase) + (voff)[_i]), (PG8_LAS unsigned*)(lds + (bufoff) + ldsw + _i * 8192), 16, 0, 0); } while (0)
#define PG8_LDA(dst, b, h) do { _Pragma("unroll") for (int m = 0; m < 4; ++m) _Pragma("unroll") for (int k = 0; k < 2; ++k) dst[m][k] = *(const PG8_LAS bf16x8*)(lds + PG8_SA(b, h) + aoff + m * 2048 + k * 1024); } while (0)
#define PG8_LDB(dst, b, h) do { _Pragma("unroll") for (int n = 0; n < 2; ++n) _Pragma("unroll") for (int k = 0; k < 2; ++k) dst[n][k] = *(const PG8_LAS bf16x8*)(lds + PG8_SB(b, h) + boff + n * 2048 + k * 1024); } while (0)
#define PG8_MMA(ai, bj, At, Bt) do { __builtin_amdgcn_s_setprio(1); _Pragma("unroll") for (int m = 0; m < 4; ++m) _Pragma("unroll") for (int n = 0; n < 2; ++n) _Pragma("unroll") for (int k = 0; k < 2; ++k) \
        acc[ai][bj][m][n] = __builtin_amdgcn_mfma_f32_16x16x32_bf16(Bt[n][k], At[m][k], acc[ai][bj][m][n], 0, 0, 0); __builtin_amdgcn_s_setprio(0); } while (0)
#define PG8_WAIT_V(n) asm volatile("s_waitcnt vmcnt(" #n ")" ::: "memory")
#define PG8_WAIT_L(n) asm volatile("s_waitcnt lgkmcnt(" #n ")" ::: "memory")
#define PG8_BAR __builtin_amdgcn_s_barrier()
#define PG8_SCHED __builtin_amdgcn_sched_barrier(0)
    Unit cur, nxt; int ui = 0;
    if (!S.next(0, cur)) return;
    f32x4 acc[2][2][4][2];
#pragma unroll
    for (int a = 0; a < 2; ++a)
#pragma unroll
        for (int b = 0; b < 2; ++b)
#pragma unroll
            for (int m = 0; m < 4; ++m)
#pragma unroll
                for (int n = 0; n < 2; ++n) acc[a][b][m][n] = (f32x4){0.f, 0.f, 0.f, 0.f};
    bf16x8 At[4][2], B0[2][2], B1[2][2];
    const char* cA = (const char*)g.A + (size_t)cur.pm * tstep; const char* cB = (const char*)g.Bt + (size_t)cur.pn * tstep;
    S.a_ready(cur);
    if constexpr (SP2) {
        PG8_STAGE(PG8_SB(0, 0), cB, voffB); PG8_STAGE(PG8_SB(0, 1), cB + hstep, voffB); PG8_STAGE(PG8_SA(0, 0), cA, voffA); PG8_STAGE(PG8_SA(0, 1), cA + hstep, voffA);
        if (wr == 1) PG8_BAR;
        PG8_WAIT_V(2); PG8_BAR;
        PG8_STAGE(PG8_SB(1, 0), cB + kstep, voffB); PG8_STAGE(PG8_SA(1, 0), cA + kstep, voffA); PG8_STAGE(PG8_SB(1, 1), cB + hstep + kstep, voffB);
        PG8_WAIT_V(6); PG8_BAR;
    } else {
        PG8_STAGE(PG8_SB(0, 0), cB, voffB); PG8_STAGE(PG8_SA(0, 0), cA, voffA); PG8_STAGE(PG8_SB(0, 1), cB + hstep, voffB); PG8_STAGE(PG8_SA(0, 1), cA + hstep, voffA);
        if (wr == 1) PG8_BAR;
        PG8_WAIT_V(4); PG8_BAR;
        PG8_STAGE(PG8_SB(1, 0), cB + kstep, voffB); PG8_STAGE(PG8_SA(1, 0), cA + kstep, voffA); PG8_STAGE(PG8_SB(1, 1), cB + hstep + kstep, voffB);
        PG8_WAIT_V(6); PG8_BAR;
    }
    for (;;) {
        const bool has_next = S.next(ui + 1, nxt);
        const char* nA = has_next ? (const char*)g.A + (size_t)nxt.pm * tstep : cA; const char* nB = has_next ? (const char*)g.Bt + (size_t)nxt.pn * tstep : cB;
        for (int t = 0; t < nt; t += 2) {
            const bool last = (t == nt - 2);
            const char* a1 = cA + (size_t)(t + 1) * kstep;
            const char* a2 = last ? nA : cA + (size_t)(t + 2) * kstep; const char* b2 = last ? nB : cB + (size_t)(t + 2) * kstep;
            const char* a3 = a2 + kstep; const char* b3 = b2 + kstep;
            if (last && has_next) S.a_ready(nxt);
            if constexpr (SP2) {
            PG8_LDB(B0, 0, 0); PG8_LDB(B1, 0, 1); PG8_SCHED; PG8_LDA(At, 0, 0); PG8_STAGE(PG8_SA(1, 1), a1 + hstep, voffA);
            PG8_WAIT_V(8); PG8_WAIT_L(0); PG8_BAR; PG8_MMA(0, 0, At, B0); PG8_MMA(0, 1, At, B1); PG8_BAR; PG8_SCHED;
            PG8_LDA(At, 0, 1); PG8_STAGE(PG8_SB(0, 0), b2, voffB); PG8_STAGE(PG8_SB(0, 1), b2 + hstep, voffB); PG8_STAGE(PG8_SA(0, 0), a2, voffA);
            PG8_WAIT_V(8); PG8_WAIT_L(0); PG8_BAR; PG8_MMA(1, 0, At, B0); PG8_MMA(1, 1, At, B1); PG8_BAR; PG8_SCHED;
            PG8_LDB(B0, 1, 0); PG8_LDB(B1, 1, 1); PG8_SCHED; PG8_LDA(At, 1, 0); PG8_STAGE(PG8_SA(0, 1), a2 + hstep, voffA);
            PG8_WAIT_V(8); PG8_WAIT_L(0); PG8_BAR; PG8_MMA(0, 0, At, B0); PG8_MMA(0, 1, At, B1); PG8_BAR; PG8_SCHED;
            PG8_LDA(At, 1, 1); PG8_STAGE(PG8_SB(1, 0), b3, voffB); PG8_STAGE(PG8_SB(1, 1), b3 + hstep, voffB); PG8_STAGE(PG8_SA(1, 0), a3, voffA);
            PG8_WAIT_V(8); PG8_WAIT_L(0); PG8_BAR; PG8_MMA(1, 0, At, B0); PG8_MMA(1, 1, At, B1); PG8_BAR; PG8_SCHED;
            } else {
            PG8_LDB(B0, 0, 0); PG8_SCHED; PG8_LDA(At, 0, 0); PG8_STAGE(PG8_SA(1, 1), a1 + hstep, voffA);
            PG8_WAIT_L(8); PG8_BAR; PG8_WAIT_L(0); PG8_MMA(0, 0, At, B0); PG8_BAR; PG8_SCHED;
            PG8_LDB(B1, 0, 1); PG8_STAGE(PG8_SB(0, 0), b2, voffB);
            PG8_BAR; PG8_WAIT_L(0); PG8_MMA(0, 1, At, B1); PG8_BAR;
            PG8_LDA(At, 0, 1); PG8_STAGE(PG8_SA(0, 0), a2, voffA);
            PG8_BAR; PG8_WAIT_L(0); PG8_MMA(1, 0, At, B0); PG8_BAR; PG8_SCHED;
            PG8_STAGE(PG8_SB(0, 1), b2 + hstep, voffB);
            PG8_WAIT_V(6); PG8_BAR; PG8_MMA(1, 1, At, B1); PG8_BAR;
            PG8_LDB(B0, 1, 0); PG8_SCHED; PG8_LDA(At, 1, 0); PG8_STAGE(PG8_SA(0, 1), a2 + hstep, voffA);
            PG8_WAIT_L(8); PG8_BAR; PG8_WAIT_L(0); PG8_MMA(0, 0, At, B0); PG8_BAR; PG8_SCHED;
            PG8_LDB(B1, 1, 1); PG8_STAGE(PG8_SB(1, 0), b3, voffB);
            PG8_BAR; PG8_WAIT_L(0); PG8_MMA(0, 1, At, B1); PG8_BAR;
            PG8_LDA(At, 1, 1); PG8_STAGE(PG8_SA(1, 0), a3, voffA);
            PG8_BAR; PG8_WAIT_L(0); PG8_MMA(1, 0, At, B0); PG8_BAR; PG8_SCHED;
            PG8_STAGE(PG8_SB(1, 1), b3 + hstep, voffB);
            PG8_WAIT_V(6); PG8_BAR; PG8_MMA(1, 1, At, B1); PG8_BAR;
            }
        }
        if constexpr (ALIGN_EPI) { if (wr == 0) PG8_BAR; }
        if constexpr (!Epi::AFTER_DRAIN) { E(acc, cur, wr, wc, fr, fq); S.done(cur); }
        if (!has_next) break;
#pragma unroll
        for (int a = 0; a < 2; ++a)
#pragma unroll
            for (int b = 0; b < 2; ++b)
#pragma unroll
                for (int m = 0; m < 4; ++m)
#pragma unroll
                    for (int n = 0; n < 2; ++n) acc[a][b][m][n] = (f32x4){0.f, 0.f, 0.f, 0.f};
        cur = nxt; cA = nA; cB = nB; ++ui;
        if constexpr (ALIGN_EPI) { if (wr == 1) PG8_BAR; }
    }
    PG8_WAIT_V(0);
    if constexpr (!ALIGN_EPI) { if (wr == 0) PG8_BAR; }
    PG8_BAR;
    if constexpr (Epi::AFTER_DRAIN) { E.fused(acc, cur, wr, wc, fr, fq, lds, wid, lane); S.done(cur); }
#undef PG8_SA
#undef PG8_SB
#undef PG8_STAGE
#undef PG8_LDA
#undef PG8_LDB
#undef PG8_MMA
#undef PG8_WAIT_V
#undef PG8_WAIT_L
#undef PG8_BAR
#undef PG8_SCHED
}
}
using namespace pg8;
#define LAS __attribute__((address_space(3)))
typedef float f32x16 __attribute__((ext_vector_type(16)));
typedef short s16x4 __attribute__((ext_vector_type(4)));
typedef __bf16 bf16x2_t __attribute__((ext_vector_type(2)));

#ifndef ONE_LAUNCH
#define ONE_LAUNCH 1
#endif
constexpr int NWAVES = 8, NTHREADS = 512;
constexpr int LDS_BYTES = 147456;
constexpr float LOG2E = 1.4426950408889634f;
constexpr float EPS = 1e-6f;

struct Args { const float* in[26]; float* p_out; unsigned char* p_ws; };

__device__ __forceinline__ float shx(float v, int o, int lane) { return __int_as_float(__builtin_amdgcn_ds_bpermute((lane ^ o) << 2, __float_as_int(v))); }
__device__ __forceinline__ float wave_sum(float v, int lane) {
#pragma unroll
    for (int o = 1; o < 64; o <<= 1) v += shx(v, o, lane);
    return v;
}
__device__ __forceinline__ unsigned f2bf(float f) { unsigned u = __builtin_bit_cast(unsigned, f); return (u + 0x7fffu + ((u >> 16) & 1u)) >> 16; }
__device__ __forceinline__ unsigned pk2(float lo, float hi) { return f2bf(lo) | (f2bf(hi) << 16); }

__device__ __forceinline__ void transpose_item(const float* W, int K, int N, bf16_t* WT, LAS float* scr, int item, int lane) {
    const int nblk = N / 32, kb = item / nblk, nb = item % nblk, k0 = 64 * kb, n0 = 32 * nb;
#pragma unroll
    for (int i = 0; i < 32; ++i) { const int kk = 2 * i + (lane >> 5); scr[kk * 33 + (lane & 31)] = W[(size_t)(k0 + kk) * N + n0 + (lane & 31)]; }
    asm volatile("s_waitcnt lgkmcnt(0)" ::: "memory");
    const int c = lane & 7;
#pragma unroll
    for (int j = 0; j < 4; ++j) { const int n = (lane >> 3) + 8 * j; const LAS float* s = scr + (8 * c) * 33 + n;
        u32x4 o; o.x = pk2(s[0 * 33], s[1 * 33]); o.y = pk2(s[2 * 33], s[3 * 33]); o.z = pk2(s[4 * 33], s[5 * 33]); o.w = pk2(s[6 * 33], s[7 * 33]);
        *(u32x4*)(WT + (size_t)(n0 + n) * K + k0 + 8 * c) = o; }
    asm volatile("s_waitcnt lgkmcnt(0)" ::: "memory");
}

__device__ __forceinline__ void fold_item(const float* wgrp, const float* scale, const float* wpp, bf16_t* WcT, int item, int lane) {
    const int kb = item >> 2, nc = item & 3, k0 = kb * 8, g = k0 >> 7, n0 = nc * 256 + lane * 4;
    f32x4 acc[8];
#pragma unroll
    for (int i = 0; i < 8; ++i) acc[i] = (f32x4){0.f, 0.f, 0.f, 0.f};
#pragma unroll 8
    for (int d = 0; d < 128; ++d) {
        const f32x4 w = *(const f32x4*)(wpp + (size_t)(g * 128 + d) * 1024 + n0) * scale[g * 128 + d];
#pragma unroll
        for (int i = 0; i < 8; ++i) acc[i] += w * wgrp[(size_t)(k0 + i) * 128 + d];
    }
#pragma unroll
    for (int j = 0; j < 4; ++j) { u32x4 o; o.x = pk2(acc[0][j], acc[1][j]); o.y = pk2(acc[2][j], acc[3][j]); o.z = pk2(acc[4][j], acc[5][j]); o.w = pk2(acc[6][j], acc[7][j]);
        *(u32x4*)(WcT + (size_t)(n0 + j) * 512 + k0) = o; }
}

__device__ __forceinline__ void norm_rows_bf16(const float* xp, const float* xs, const float* g, bf16_t* HB, int gw, int ngw, int lane) {
    f32x4 gv[4];
#pragma unroll
    for (int j = 0; j < 4; ++j) gv[j] = ((const f32x4*)g)[lane + 64 * j];
    f32x4 nx[4];
    if (gw < MT) { const f32x4* xr = (const f32x4*)(gw < MP ? xp + (size_t)gw * DM : xs + (size_t)(gw - MP) * DM) + lane;
#pragma unroll
        for (int j = 0; j < 4; ++j) nx[j] = xr[64 * j]; }
    for (int m = gw; m < MT; m += ngw) {
        f32x4 v[4]; float s = 0.f;
#pragma unroll
        for (int j = 0; j < 4; ++j) v[j] = nx[j];
        const int mn = m + ngw;
        if (mn < MT) { const f32x4* xr = (const f32x4*)(mn < MP ? xp + (size_t)mn * DM : xs + (size_t)(mn - MP) * DM) + lane;
#pragma unroll
            for (int j = 0; j < 4; ++j) nx[j] = xr[64 * j]; }
#pragma unroll
        for (int j = 0; j < 4; ++j) s += (v[j].x * v[j].x + v[j].y * v[j].y) + (v[j].z * v[j].z + v[j].w * v[j].w);
        const float r = 1.0f / sqrtf(wave_sum(s, lane) * (1.0f / DM) + EPS);
        unsigned long long* o8 = (unsigned long long*)(HB + (size_t)m * DM) + lane;
#pragma unroll
        for (int j = 0; j < 4; ++j) { const f32x4 y = v[j] * r * gv[j]; o8[64 * j] = (unsigned long long)pk2(y.x, y.y) | ((unsigned long long)pk2(y.z, y.w) << 32); }
    }
}
__device__ __forceinline__ void norm_rows_f32(float* X, const float* g, int gw, int ngw, int lane) {
    f32x4 gv[4];
#pragma unroll
    for (int j = 0; j < 4; ++j) gv[j] = ((const f32x4*)g)[lane + 64 * j];
    for (int m = gw; m < MT; m += ngw) {
        f32x4* xr = (f32x4*)(X + (size_t)m * DM) + lane;
        f32x4 v[4]; float s = 0.f;
#pragma unroll
        for (int j = 0; j < 4; ++j) { v[j] = xr[64 * j]; s += (v[j].x * v[j].x + v[j].y * v[j].y) + (v[j].z * v[j].z + v[j].w * v[j].w); }
        const float r = 1.0f / sqrtf(wave_sum(s, lane) * (1.0f / DM) + EPS);
#pragma unroll
        for (int j = 0; j < 4; ++j) xr[64 * j] = v[j] * r * gv[j];
    }
}

__device__ __forceinline__ bf16x8 pack_p(const f32x16& x, int s) {
    u32x4 p;
#pragma unroll
    for (int j = 0; j < 4; ++j) { f32x2 v = {x[8 * s + 2 * j], x[8 * s + 2 * j + 1]}; bf16x2_t b = __builtin_convertvector(v, bf16x2_t); p[j] = __builtin_bit_cast(unsigned, b); }
    return __builtin_bit_cast(bf16x8, p);
}

template <int NQ>
__device__ __forceinline__ void attn_unit(const bf16_t* Qp, const bf16_t* Kp, const bf16_t* Vtp, int vpitch, int kt0, int kt1, int dq0, const LAS float* tb, bf16_t* Op, int lane) {
    const int r = lane & 31, hi = lane >> 5;
    bf16x8 qf[NQ][4];
#pragma unroll
    for (int qi = 0; qi < NQ; ++qi)
#pragma unroll
        for (int s = 0; s < 4; ++s) qf[qi][s] = *(const bf16x8*)(Qp + (size_t)(32 * qi + r) * 512 + 32 * hi + 8 * s);
    f32x16 o[2][NQ]; float mrun[NQ], lrun[NQ];
#pragma unroll
    for (int qi = 0; qi < NQ; ++qi) { mrun[qi] = -1e30f; lrun[qi] = 0.f;
#pragma unroll
        for (int di = 0; di < 2; ++di)
#pragma unroll
            for (int i = 0; i < 16; ++i) o[di][qi][i] = 0.f; }
    const float bconst = tb[256];
    for (int kt = kt0; kt < kt1; ++kt) {
        const bf16_t* kp = Kp + ((long)(kt * 32 + r)) * 512 + 32 * hi;
        bf16x8 kf[4];
#pragma unroll
        for (int s = 0; s < 4; ++s) kf[s] = *(const bf16x8*)(kp + 8 * s);
        bf16x8 vf[2][2];
#pragma unroll
        for (int di = 0; di < 2; ++di)
#pragma unroll
            for (int ks = 0; ks < 2; ++ks) { const bf16_t* vp = Vtp + (long)(32 * di + r) * vpitch + kt * 32 + 16 * ks + 4 * hi;
                const s16x4 lo = *(const s16x4*)vp, hh = *(const s16x4*)(vp + 8); vf[di][ks] = __builtin_shufflevector(lo, hh, 0, 1, 2, 3, 4, 5, 6, 7); }
#pragma unroll
        for (int qi = 0; qi < NQ; ++qi) {
            f32x16 s;
#pragma unroll
            for (int i = 0; i < 16; ++i) s[i] = 0.f;
#pragma unroll
            for (int st = 0; st < 4; ++st) s = __builtin_amdgcn_mfma_f32_32x32x16_bf16(kf[st], qf[qi][st], s, 0, 0, 0);
            const int dmin = dq0 + 32 * qi - kt * 32 - 31;
            if (dmin >= 128) {
#pragma unroll
                for (int i = 0; i < 16; ++i) s[i] = s[i] * LOG2E + bconst;
            } else {
                const int dbase = dq0 + 32 * qi + r - kt * 32 - 4 * hi;
#pragma unroll
                for (int i = 0; i < 16; ++i) { int dd = dbase - ((i & 3) + 8 * (i >> 2)); dd = dd < -128 ? -128 : (dd > 128 ? 128 : dd); s[i] = s[i] * LOG2E + tb[dd + 128]; }
            }
            float mx = s[0];
#pragma unroll
            for (int i = 1; i < 16; ++i) mx = fmaxf(mx, s[i]);
            mx = fmaxf(mx, shx(mx, 32, lane));
            const float mn = fmaxf(mrun[qi], mx), alpha = __builtin_amdgcn_exp2f(mrun[qi] - mn); mrun[qi] = mn;
            float ps = 0.f;
#pragma unroll
            for (int i = 0; i < 16; ++i) { s[i] = __builtin_amdgcn_exp2f(s[i] - mn); ps += s[i]; }
            lrun[qi] = lrun[qi] * alpha + ps;
#pragma unroll
            for (int di = 0; di < 2; ++di)
#pragma unroll
                for (int i = 0; i < 16; ++i) o[di][qi][i] *= alpha;
#pragma unroll
            for (int ks = 0; ks < 2; ++ks) { const bf16x8 pf = pack_p(s, ks);
#pragma unroll
                for (int di = 0; di < 2; ++di) o[di][qi] = __builtin_amdgcn_mfma_f32_32x32x16_bf16(vf[di][ks], pf, o[di][qi], 0, 0, 0); }
        }
    }
#pragma unroll
    for (int qi = 0; qi < NQ; ++qi) {
        const float lt = lrun[qi] + shx(lrun[qi], 32, lane), inv = 1.0f / lt;
#pragma unroll
        for (int di = 0; di < 2; ++di)
#pragma unroll
            for (int g = 0; g < 4; ++g) {
                const unsigned lo = cvt_pk_bf16(o[di][qi][4 * g] * inv, o[di][qi][4 * g + 1] * inv), hh = cvt_pk_bf16(o[di][qi][4 * g + 2] * inv, o[di][qi][4 * g + 3] * inv);
                *(unsigned long long*)(Op + (size_t)(32 * qi + r) * 512 + 32 * di + 8 * g + 4 * hi) = (unsigned long long)lo | ((unsigned long long)hh << 32);
            }
    }
}

#define XB_TMO      128
#define XB_XCNT(j)  (256  + 64 * (j))
#define XB_XSUB(j)  (1280 + 64 * (j))
#define XB_XGEN(j)  (2304 + 64 * (j))
#define XB_TOP      3328
#define XB_TOPGEN   3392
#define XCD_BAR_WORDS 3456
#define XB_SPIN_CAP (1u << 18)

__device__ __forceinline__ unsigned xb_ld(unsigned* p)              { return __hip_atomic_load(p, __ATOMIC_RELAXED, __HIP_MEMORY_SCOPE_AGENT); }
__device__ __forceinline__ unsigned xb_add(unsigned* p, unsigned v) { return __hip_atomic_fetch_add(p, v, __ATOMIC_RELAXED, __HIP_MEMORY_SCOPE_AGENT); }
__device__ __forceinline__ unsigned xb_xcc_id() { return (unsigned)__builtin_amdgcn_s_getreg((3 << 11) | 20) & 0xFu; }
#define XB_SPIN(cond, bar) do { unsigned _sp = 0; while (cond) { __builtin_amdgcn_s_sleep(1); \
    if ((++_sp & 255u) == 0u) { if (xb_ld(&(bar)[XB_TMO])) break; if (_sp > XB_SPIN_CAP) { atomicAdd(&(bar)[XB_TMO], 1u); break; } } } } while (0)

struct XcdBarrier {
    unsigned* bar; unsigned x;
    volatile LAS unsigned* st;
};

__device__ __forceinline__ XcdBarrier xcd_barrier_post(unsigned* bar, volatile LAS unsigned* st) {
    XcdBarrier b; b.bar = bar; b.x = xb_xcc_id(); b.st = st;
    if (threadIdx.x == 0) (void)xb_add(&bar[XB_XCNT(b.x)], 1u);
    return b;
}
__device__ __forceinline__ void xcd_barrier_complete(unsigned* bar, unsigned x, unsigned& nloc, unsigned& nx) {
    const unsigned G = gridDim.x * gridDim.y * gridDim.z;
    unsigned sum, cnt, mine, sp = 0u;
    for (;;) {
        sum = 0u; cnt = 0u; mine = 0u;
#pragma unroll
        for (unsigned j = 0; j < 16; ++j) { const unsigned c = xb_ld(&bar[XB_XCNT(j)]); sum += c; cnt += (c > 0u) ? 1u : 0u; mine = (j == x) ? c : mine; }
        if (sum == G) break;
        __builtin_amdgcn_s_sleep(1);
        if ((++sp & 255u) == 0u) { if (xb_ld(&bar[XB_TMO])) break; if (sp > XB_SPIN_CAP) { atomicAdd(&bar[XB_TMO], 1u); break; } }
    }
    nloc = mine > 0u ? mine : 1u; nx = cnt > 0u ? cnt : 1u;
}

__device__ __forceinline__ void xcd_barrier(const XcdBarrier& b) {
    asm volatile("s_waitcnt vmcnt(0)" ::: "memory");
    __syncthreads();
    if (threadIdx.x == 0) {
        unsigned* bar = b.bar;
        __builtin_amdgcn_s_waitcnt(0);
        unsigned nloc = b.st[0], nx = b.st[1];
        if (nloc == 0u) { xcd_barrier_complete(bar, b.x, nloc, nx); b.st[0] = nloc; b.st[1] = nx; }
        const unsigned old = xb_add(&bar[XB_XSUB(b.x)], 1u);
        const unsigned gen = old / nloc;
        if (old + 1u == (gen + 1u) * nloc) {
            __builtin_amdgcn_fence(__ATOMIC_RELEASE, "agent");
            asm volatile("s_waitcnt vmcnt(0)" ::: "memory");
            const unsigned og = xb_add(&bar[XB_TOP], 1u);
            const unsigned tg = og / nx;
            if (og + 1u == (tg + 1u) * nx) xb_add(&bar[XB_TOPGEN], 1u);
            else XB_SPIN(xb_ld(&bar[XB_TOPGEN]) == tg, bar);
            __builtin_amdgcn_fence(__ATOMIC_ACQUIRE, "agent");
            xb_add(&bar[XB_XGEN(b.x)], 1u);
            asm volatile("s_waitcnt vmcnt(0)" ::: "memory");
        } else {
            XB_SPIN(xb_ld(&bar[XB_XGEN(b.x)]) == gen, bar);
            __builtin_amdgcn_fence(__ATOMIC_ACQUIRE, "agent");
            asm volatile("s_waitcnt vmcnt(0)" ::: "memory");
        }
    }
    __syncthreads();
}

#define ARGTAB_OFF (131072 + 256)
__device__ __forceinline__ const void* arg_ptr(LAS unsigned char* lds, int i) {
    const unsigned long long v = *(const LAS unsigned long long*)(lds + ARGTAB_OFF + 8 * i);
    const unsigned lo = __builtin_amdgcn_readfirstlane((unsigned)v), hi = __builtin_amdgcn_readfirstlane((unsigned)(v >> 32));
    return (const void*)(((unsigned long long)hi << 32) | lo);
}
#define ARG(i) arg_ptr(lds, (i))
#define GRID_SYNC() do { if (STEP < 0) { XcdBarrier xb_; xb_.bar = (unsigned*)ARG(27); xb_.x = xb_xcc_id(); xb_.st = (volatile LAS unsigned*)(lds + 131072); xcd_barrier(xb_); } } while (0)
#define RUNP(p) (STEP < 0 || STEP == 11 * l + (p) - 1)
#define FRESH_IDS() int tid_ = threadIdx.x; asm volatile("" : "+v"(tid_)); const int tid = tid_, lane = tid & 63, wave = __builtin_amdgcn_readfirstlane(tid >> 6), gw = blockIdx.x * NWAVES + wave, gtid = blockIdx.x * NTHREADS + tid; (void)gw; (void)gtid; (void)lane;
#define x_prompt ((const float*)ARG(0))
#define x_sample ((const float*)ARG(1))
#define cache_pool ((const float*)ARG(2))
#define cache_k ((const float*)ARG(3))
#define cache_v ((const float*)ARG(4))
#define cache_conv ((const float*)ARG(5))
#define p_prompt ((const float*)ARG(6))
#define p_sample ((const float*)ARG(7))
#define g_mix ((const float*)ARG(8))
#define w_in ((const float*)ARG(9))
#define b_gate ((const float*)ARG(10))
#define w_pool_grp ((const float*)ARG(11))
#define pool_scale ((const float*)ARG(12))
#define rel_bias ((const float*)ARG(13))
#define w_pool_proj ((const float*)ARG(14))
#define w_attn_proj ((const float*)ARG(15))
#define w_out ((const float*)ARG(16))
#define g_ffn ((const float*)ARG(17))
#define w_up ((const float*)ARG(18))
#define w_dw ((const float*)ARG(19))
#define b_dw ((const float*)ARG(20))
#define w_down ((const float*)ARG(21))
#define g_ple ((const float*)ARG(22))
#define w_ple ((const float*)ARG(23))
#define w_ple_gate ((const float*)ARG(24))
#define g_final ((const float*)ARG(25))
#define HB ((bf16_t*)(ws + WS_HB))
#define MG RP(R_MG)
#define HB3 RP(R_HB3)
#define RP(off) ((bf16_t*)(ws + WS_R + (off)))
#define Ub RP(R_U)
#define Qb RP(R_Q)
#define Kb RP(R_K)
#define Vtb RP(R_VT)
#define Gb RP(R_G)
#define Db RP(R_D)
#define Ksb RP(R_KS)
#define Vtsb RP(R_VTS)
#define Aup RP(R_A)
#define ACT RP(R_ACT)
#define Pb RP(R_PB)
#define Tb RP(R_T)

template <int MODE> struct SGate {
    bf16_t* O; const bf16_t* G; int goff;
    __device__ __forceinline__ void operator()(int row, int col, float v) const {
        bf16_t* op = O + (size_t)row * 1024 + col;
        if (MODE >= 1) v *= bflo(G[(size_t)row * 2048 + goff + col]);
        if (MODE == 2) v += bflo(*op);
        *op = (bf16_t)(cvt_pk_bf16(v, 0.f) & 0xffffu);
    }
};
struct SRes { const float* base; float* Xo; __device__ __forceinline__ void operator()(int row, int col, float v) const { const size_t o = (size_t)row * DM + col; Xo[o] = base[o] + v; } };
struct SPle { const bf16_t* T; float* Xo; __device__ __forceinline__ void operator()(int row, int col, float v) const { const size_t o = (size_t)row * DM + col; Xo[o] += bflo(T[o]) * sigmoidf_(v); } };
template <class F>
__device__ __forceinline__ void small_gemm(LAS unsigned char* lds, const bf16_t* A, const bf16_t* Bt, int K, const F& f) {
    int tid_ = threadIdx.x; asm volatile("" : "+v"(tid_));
    const int tid = tid_, lane = tid & 63, wave = __builtin_amdgcn_readfirstlane(tid >> 6), r = lane & 31, hi = lane >> 5, kw = K >> 3;
    LAS float* red = (LAS float*)lds;
    for (int tile = blockIdx.x; tile < 256; tile += gridDim.x) {
        const int half = (tile >> 3) & 1, q = (tile & 7) + 8 * (tile >> 4), r0 = MP + (q >> 4) * 32, c0 = (2 * (q & 15) + half) * 32;
        const bf16_t* ap = A + (size_t)(r0 + r) * K + wave * kw + 8 * hi; const bf16_t* bp = Bt + (size_t)(c0 + r) * K + wave * kw + 8 * hi;
        f32x16 acc;
#pragma unroll
        for (int i = 0; i < 16; ++i) acc[i] = 0.f;
#pragma unroll 2
        for (int k = 0; k < kw; k += 16) acc = __builtin_amdgcn_mfma_f32_32x32x16_bf16(*(const bf16x8*)(ap + k), *(const bf16x8*)(bp + k), acc, 0, 0, 0);
#pragma unroll
        for (int i = 0; i < 16; ++i) red[(wave * 16 + i) * 64 + lane] = acc[i];
        __syncthreads();
#pragma unroll
        for (int h = 0; h < 2; ++h) { const int e = tid + 512 * h, i = e >> 6, ln = e & 63; float v = 0.f;
#pragma unroll
            for (int w = 0; w < 8; ++w) v += red[w * 1024 + e];
            f(r0 + (i & 3) + 8 * (i >> 2) + 4 * (ln >> 5), c0 + (ln & 31), v); }
        __syncthreads();
    }
}

__device__ __forceinline__ void convert_weights(LAS unsigned char* lds, int l, int vw, int nvw, int wave, int lane) {
    LAS float* scr = (LAS float*)(lds + wave * 16384);
    constexpr int I_IN = 16 * 128, I_AP = 8 * 32, I_OUT = 16 * 32, I_UP = 16 * 176, I_DOWN = 44 * 32, I_PLE = 4 * 32, I_PG = 16 * 32;
    constexpr int I_LAYER = I_IN + I_AP + I_OUT + I_UP + I_DOWN + I_PLE + I_PG;
    unsigned char* wl = (unsigned char*)ARG(27) + WS_W + (size_t)l * WL_SIZE;
    const int nfold = nvw > 1024 ? 256 : 0;
    if (vw >= nfold) for (int it = vw - nfold; it < I_LAYER; it += nvw - nfold) { int rr = it;
        if (rr < I_IN) { transpose_item(w_in + (size_t)l * 1024 * 4096, 1024, 4096, (bf16_t*)(wl + WL_IN), scr, rr, lane); continue; } rr -= I_IN;
        if (rr < I_AP) { transpose_item(w_attn_proj + (size_t)l * 512 * 1024, 512, 1024, (bf16_t*)(wl + WL_AP), scr, rr, lane); continue; } rr -= I_AP;
        if (rr < I_OUT) { transpose_item(w_out + (size_t)l * 1024 * 1024, 1024, 1024, (bf16_t*)(wl + WL_OUT), scr, rr, lane); continue; } rr -= I_OUT;
        if (rr < I_UP) { transpose_item(w_up + (size_t)l * 1024 * 5632, 1024, 5632, (bf16_t*)(wl + WL_UP), scr, rr, lane); continue; } rr -= I_UP;
        if (rr < I_DOWN) { transpose_item(w_down + (size_t)l * 2816 * 1024, 2816, 1024, (bf16_t*)(wl + WL_DOWN), scr, rr, lane); continue; } rr -= I_DOWN;
        if (rr < I_PLE) { transpose_item(w_ple + (size_t)l * 256 * 1024, 256, 1024, (bf16_t*)(wl + WL_PLE), scr, rr, lane); continue; } rr -= I_PLE;
        transpose_item(w_ple_gate + (size_t)l * 1024 * 1024, 1024, 1024, (bf16_t*)(wl + WL_PG), scr, rr, lane);
    }
    if (vw < nfold || nfold == 0) for (int it = vw; it < 256; it += (nfold ? nfold : nvw))
        fold_item(w_pool_grp + (size_t)l * 4 * 128 * 128, pool_scale + l * 512, w_pool_proj + (size_t)l * 512 * 1024, (bf16_t*)(wl + WL_C), it, lane);
}

template <int L, int STEP>
__device__ __forceinline__ void layer_body(LAS unsigned char* lds) {
    constexpr int l = L;
    const int G = gridDim.x, ngw = G * NWAVES, ngt = G * NTHREADS;
#define ws ((unsigned char*)ARG(27))
#define out ((float*)ARG(26))
#define X out

#define WLP(off) ((const bf16_t*)(ws + WS_W + (size_t)l * WL_SIZE + (off)))
#define Win_t WLP(WL_IN)
#define Wc_t WLP(WL_C)
#define Wap_t WLP(WL_AP)
#define Wout_t WLP(WL_OUT)
#define Wup_t WLP(WL_UP)
#define Wdown_t WLP(WL_DOWN)
#define Wple_t WLP(WL_PLE)
#define Wpg_t WLP(WL_PG)
        if (RUNP(1))
        {
        FRESH_IDS();
        norm_rows_bf16(l == 0 ? x_prompt : X, l == 0 ? x_sample : X + (size_t)MP * DM, g_mix + l * DM, HB, gw, ngw, lane);
            const float* ck = cache_k + (size_t)l * DBATCH * KCACHE * 512; const float* cv = cache_v + (size_t)l * DBATCH * KCACHE * 512;
            for (int i = gtid; i < DBATCH * KCACHE * 64; i += ngt) { const int b = i >> 15, rem = i & 32767, rw = rem >> 6, c8 = (rem & 63) * 8;
                const float* s = ck + ((size_t)b * KCACHE + rw) * 512 + c8; const f32x4 a = *(const f32x4*)s, bq = *(const f32x4*)(s + 4);
                *(u32x4*)(Ksb + ((size_t)b * KS_ROWS + rw) * 512 + c8) = pack8(a, bq); }
            for (int it = gw; it < DBATCH * 8 * 64; it += ngw) { const int b = it >> 9, h = (it >> 6) & 7, p0 = (it & 63) * 8;
                float v[8];
#pragma unroll
                for (int j = 0; j < 8; ++j) v[j] = cv[((size_t)b * KCACHE + p0 + j) * 512 + h * 64 + lane];
                u32x4 o; o.x = pk2(v[0], v[1]); o.y = pk2(v[2], v[3]); o.z = pk2(v[4], v[5]); o.w = pk2(v[6], v[7]);
                *(u32x4*)(Vtsb + ((size_t)(b * 8 + h) * 64 + lane) * KS_ROWS + p0) = o; }
        }
        GRID_SYNC();
        if (RUNP(2))
        { Gemm g{HB, Win_t, MT, 4096, 1024}; StaticOrder S; S.init(MT, 4096, G, (int)blockIdx.x);
          EpiG1 E{ws, b_gate + l * 2048, l, out};
          gemm_phase<EpiG1, StaticOrder, true, true>(lds, g, S, E);
          if (l == 0 && STEP < 0) {
              constexpr int nwg = (MT / 256) * 16; int busy = nwg - ((nwg - 1) / G) * G; if (busy >= G) busy = 0;
              if ((int)blockIdx.x >= busy) { FRESH_IDS(); convert_weights(lds, 1, ((int)blockIdx.x - busy) * NWAVES + wave, (G - busy) * NWAVES, wave, lane); } } }
        GRID_SYNC();
        if (RUNP(3))
        {
            FRESH_IDS();
            const float* cp = cache_pool + (size_t)l * DBATCH * 15 * 512;
            for (int i = gtid; i < MT * 64; i += ngt) { const int row = i >> 6, c8 = (i & 63) * 8, w = 2 << (c8 >> 7);
                f32x4 s0 = {0.f, 0.f, 0.f, 0.f}, s1 = s0, u0, u1; float cnt;
                unpack8(*(const u32x4*)(Ub + (size_t)row * 512 + c8), u0, u1);
                if (row < MP) { const int t = row & 2047, n = (t + 1) < w ? (t + 1) : w; cnt = (float)n;
                    s0 = u0; s1 = u1;
#define POOL_TAPS(W) _Pragma("unroll") for (int j = 1; j < (W); ++j) { const bool ok = j <= t; f32x4 a, b; unpack8(*(const u32x4*)(Ub + (size_t)(ok ? row - j : row) * 512 + c8), a, b); const float mk = ok ? 1.f : 0.f; s0 += a * mk; s1 += b * mk; }
                    if (w == 2) { POOL_TAPS(2) } else if (w == 4) { POOL_TAPS(4) } else if (w == 8) { POOL_TAPS(8) } else { POOL_TAPS(16) } }
                else { const int rs = row - MP, b = rs >> 5, t = rs & 31; cnt = (float)w;
                    for (int j = 0; j < w; ++j) { const int tt = t - j; f32x4 a, bq;
                        if (tt >= 0) unpack8(*(const u32x4*)(Ub + (size_t)(row - j) * 512 + c8), a, bq);
                        else { const float* s = cp + ((size_t)b * 15 + 15 + tt) * 512 + c8; a = *(const f32x4*)s; bq = *(const f32x4*)(s + 4); }
                        s0 += a; s1 += bq; } }
                const float ic = 1.0f / cnt;
                *(u32x4*)(Db + (size_t)row * 512 + c8) = pack8(s0 * ic - u0, s1 * ic - u1); }
            LAS float* tball = (LAS float*)lds;
            for (int i = tid; i < 8 * 257; i += NTHREADS) tball[i] = rel_bias[(size_t)l * 8 * 257 + i] * LOG2E;
            __syncthreads();
            for (int ui = gw; ui < 4096 + 64; ui += ngw) {
                const int h = ui & 7; const LAS float* tb = tball + h * 257;
                if (ui < 4096) { const int bc = ui >> 3, b = bc >> 5, c = bc & 31; const long row0 = (long)b * SEQ + c * 64, krow0 = (long)b * SEQ + (long)(c - 8) * 64;
                    attn_unit<2>(Qb + row0 * 512 + h * 64, Kb + krow0 * 512 + h * 64, Vtb + ((long)(b * 8 + h) * 64) * SEQ + (long)(c - 8) * 64, SEQ, c < 8 ? (8 - c) * 2 : 0, 18, 512, tb, Qb + row0 * 512 + h * 64, lane); }
                else { const int b = (ui - 4096) >> 3; const long row0 = (long)MP + b * DSEQ;
                    attn_unit<1>(Qb + row0 * 512 + h * 64, Ksb + (long)b * KS_ROWS * 512 + h * 64, Vtsb + ((long)(b * 8 + h) * 64) * KS_ROWS, KS_ROWS, 0, 17, 512, tb, Qb + row0 * 512 + h * 64, lane); }
            }
        }
        GRID_SYNC();
        if (RUNP(4))
        { StaticOrder S; S.init(MP, 1024, G, (int)blockIdx.x);
          { Gemm g{Db, Wc_t, MP, 1024, 512}; EpiGate<1> E{MG, 1024, Gb, 0}; gemm_phase<EpiGate<1>, StaticOrder, true, true>(lds, g, S, E); }
          { Gemm g{Qb, Wap_t, MP, 1024, 512}; EpiGate<2> E{MG, 1024, Gb, 1024}; gemm_phase<EpiGate<2>, StaticOrder, true, true>(lds, g, S, E); }
          small_gemm(lds, Db, Wc_t, 512, SGate<1>{MG, Gb, 0}); small_gemm(lds, Qb, Wap_t, 512, SGate<2>{MG, Gb, 1024}); }
        GRID_SYNC();
        if (RUNP(5))
        { Gemm g{MG, Wout_t, MP, 1024, 1024}; StaticOrder S; S.init(MP, 1024, G, (int)blockIdx.x);
          EpiRes E{l == 0 ? x_prompt : X, l == 0 ? x_sample : X + (size_t)MP * DM, X}; gemm_phase<EpiRes, StaticOrder, true, true>(lds, g, S, E);
          small_gemm(lds, MG, Wout_t, 1024, SRes{l == 0 ? x_sample - (size_t)MP * DM : X, X}); }
        GRID_SYNC();
        if (RUNP(6))
        { FRESH_IDS(); norm_rows_bf16(X, X + (size_t)MP * DM, g_ffn + l * DM, HB, gw, ngw, lane); }
        GRID_SYNC();
        if (RUNP(7))
        { Gemm g{HB, Wup_t, MT, 2816, 1024}; StaticOrder S; S.init(MT, 2816, G, (int)blockIdx.x);
          EpiUpA E{Aup, out, l}; gemm_phase<EpiUpA, StaticOrder, true, true>(lds, g, S, E); }
        GRID_SYNC();
        if (RUNP(8))
        { Gemm g{HB, Wup_t + (size_t)2816 * 1024, MT, 2816, 1024}; StaticOrder S; S.init(MT, 2816, G, (int)blockIdx.x);
          EpiUpB E{Aup, ACT, w_dw + (size_t)l * 3 * DFF, b_dw + (size_t)l * DFF, cache_conv + (size_t)l * DBATCH * 2 * DFF}; gemm_phase<EpiUpB, StaticOrder, true, true>(lds, g, S, E); }
        GRID_SYNC();
        if (RUNP(9))
        { Gemm g{ACT, Wdown_t, MP, 1024, 2816}; StaticOrder S; S.init(MP, 1024, G, (int)blockIdx.x);
          EpiRes E{X, X + (size_t)MP * DM, X}; gemm_phase<EpiRes, StaticOrder, true, true>(lds, g, S, E);
          small_gemm(lds, ACT, Wdown_t, 2816, SRes{X, X}); }
        GRID_SYNC();
        if (RUNP(10))
        { FRESH_IDS(); norm_rows_bf16(X, X + (size_t)MP * DM, g_ple + l * DM, HB3, gw, ngw, lane);
          const float* pp = p_prompt + (size_t)l * MP * 256; const float* ps = p_sample + (size_t)l * MS * 256;
          for (int i = gtid; i < MT * 32; i += ngt) { const size_t e = (size_t)i * 8; const float* s = e < (size_t)MP * 256 ? pp + e : ps + (e - (size_t)MP * 256);
              const f32x4 a = *(const f32x4*)s, b = *(const f32x4*)(s + 4); *(u32x4*)(Pb + e) = pack8(a, b); } }
        GRID_SYNC();
        if (RUNP(11))
        { StaticOrder S; S.init(MP, 1024, G, (int)blockIdx.x);
          { Gemm g{Pb, Wple_t, MP, 1024, 256}; EpiGate<0> E{Tb, 1024, nullptr, 0}; gemm_phase<EpiGate<0>, StaticOrder, true, true>(lds, g, S, E); }
          { Gemm g{HB3, Wpg_t, MP, 1024, 1024}; EpiPle E{Tb, X}; gemm_phase<EpiPle, StaticOrder, true, true>(lds, g, S, E); }
          small_gemm(lds, Pb, Wple_t, 256, SGate<0>{Tb, nullptr, 0}); small_gemm(lds, HB3, Wpg_t, 1024, SPle{Tb, X}); }
        GRID_SYNC();

}

template <int STEP>
__global__ void __launch_bounds__(NTHREADS, 2) mega_fwd(Args args) {
    extern __shared__ __attribute__((aligned(16))) unsigned char lds_raw[];
    LAS unsigned char* lds = (LAS unsigned char*)lds_raw;
    cg::grid_group grid = cg::this_grid();
    const int G = gridDim.x, ngw = G * NWAVES, ngt = G * NTHREADS;
    for (int u = threadIdx.x; u < 64; u += NTHREADS) ((LAS unsigned*)(lds + 131072))[u] = 0u;
    __syncthreads();
    if (threadIdx.x == 0) { LAS unsigned long long* tab = (LAS unsigned long long*)(lds + ARGTAB_OFF);
        tab[0] = (unsigned long long)args.in[0];
        tab[1] = (unsigned long long)args.in[1];
        tab[2] = (unsigned long long)args.in[2];
        tab[3] = (unsigned long long)args.in[3];
        tab[4] = (unsigned long long)args.in[4];
        tab[5] = (unsigned long long)args.in[5];
        tab[6] = (unsigned long long)args.in[6];
        tab[7] = (unsigned long long)args.in[7];
        tab[8] = (unsigned long long)args.in[8];
        tab[9] = (unsigned long long)args.in[9];
        tab[10] = (unsigned long long)args.in[10];
        tab[11] = (unsigned long long)args.in[11];
        tab[12] = (unsigned long long)args.in[12];
        tab[13] = (unsigned long long)args.in[13];
        tab[14] = (unsigned long long)args.in[14];
        tab[15] = (unsigned long long)args.in[15];
        tab[16] = (unsigned long long)args.in[16];
        tab[17] = (unsigned long long)args.in[17];
        tab[18] = (unsigned long long)args.in[18];
        tab[19] = (unsigned long long)args.in[19];
        tab[20] = (unsigned long long)args.in[20];
        tab[21] = (unsigned long long)args.in[21];
        tab[22] = (unsigned long long)args.in[22];
        tab[23] = (unsigned long long)args.in[23];
        tab[24] = (unsigned long long)args.in[24];
        tab[25] = (unsigned long long)args.in[25];
        tab[26] = (unsigned long long)args.p_out; tab[27] = (unsigned long long)args.p_ws; }
    __syncthreads();
    if (STEP < 0) { (void)xcd_barrier_post((unsigned*)ARG(27), (volatile LAS unsigned*)(lds + 131072)); grid.sync(); }
    if (STEP < 0 || STEP == 0) {
        FRESH_IDS();
        convert_weights(lds, 0, gw, ngw, wave, lane);
        if (STEP >= 0) convert_weights(lds, 1, gw, ngw, wave, lane);
    }

    layer_body<0, STEP>(lds);
    layer_body<1, STEP>(lds);
    if (STEP < 0 || STEP == 22)
    { FRESH_IDS(); norm_rows_f32(X, g_final, gw, ngw, lane); }
}

#undef ws
#undef out
#undef X
extern "C" void kernel_launch(void* const* d_in, const int* in_sizes, int n_in, void* d_out, int out_size, void* d_ws, size_t ws_size, hipStream_t stream) {
    static int grid = 0;
    if (grid == 0) {
        if (n_in != 26 || (size_t)out_size != O_END || ws_size < WS_END) { fprintf(stderr, "kernel_launch: unexpected shapes: n_in %d out %d ws %zu (need %zu)\n", n_in, out_size, ws_size, (size_t)WS_END); grid = -1; return; }
        int dev = 0, cus = 0, per_cu = 0;
        hipGetDevice(&dev); hipDeviceGetAttribute(&cus, hipDeviceAttributeMultiprocessorCount, dev);
        if (hipFuncSetAttribute((const void*)mega_fwd<-1>, hipFuncAttributeMaxDynamicSharedMemorySize, LDS_BYTES) != hipSuccess) { fprintf(stderr, "kernel_launch: hipFuncSetAttribute failed\n"); grid = -1; return; }
        if (hipOccupancyMaxActiveBlocksPerMultiprocessor(&per_cu, (const void*)mega_fwd<-1>, NTHREADS, LDS_BYTES) != hipSuccess || per_cu < 1) { fprintf(stderr, "kernel_launch: occupancy query gives %d\n", per_cu); grid = -1; (void)hipGetLastError(); return; }
        grid = cus;
#if !ONE_LAUNCH
        { typedef void (*kfn)(Args);
          const kfn fa[23] = {mega_fwd<0>, mega_fwd<1>, mega_fwd<2>, mega_fwd<3>, mega_fwd<4>, mega_fwd<5>, mega_fwd<6>, mega_fwd<7>, mega_fwd<8>, mega_fwd<9>, mega_fwd<10>, mega_fwd<11>,
                              mega_fwd<12>, mega_fwd<13>, mega_fwd<14>, mega_fwd<15>, mega_fwd<16>, mega_fwd<17>, mega_fwd<18>, mega_fwd<19>, mega_fwd<20>, mega_fwd<21>, mega_fwd<22>};
          for (int i = 0; i < 23; ++i) if (hipFuncSetAttribute((const void*)fa[i], hipFuncAttributeMaxDynamicSharedMemorySize, LDS_BYTES) != hipSuccess) { fprintf(stderr, "kernel_launch: hipFuncSetAttribute failed for step %d\n", i); grid = -1; return; } }
#endif
    }
    if (grid < 0) return;
    if (hipMemsetAsync(d_ws, 0, 65536, stream) != hipSuccess) { fprintf(stderr, "memset failed\n"); return; }
    Args a{};
    for (int i = 0; i < 26; ++i) a.in[i] = (const float*)d_in[i];
    a.p_out = (float*)d_out; a.p_ws = (unsigned char*)d_ws;
    void* kargs[] = {&a};
#if ONE_LAUNCH
    hipError_t e = hipLaunchCooperativeKernel((const void*)mega_fwd<-1>, dim3(grid), dim3(NTHREADS), kargs, LDS_BYTES, stream);
    if (e != hipSuccess) fprintf(stderr, "cooperative launch failed: %s (grid %d)\n", hipGetErrorString(e), grid);
#else
    typedef void (*kfn)(Args);
    static const kfn fns[23] = {mega_fwd<0>, mega_fwd<1>, mega_fwd<2>, mega_fwd<3>, mega_fwd<4>, mega_fwd<5>, mega_fwd<6>, mega_fwd<7>, mega_fwd<8>, mega_fwd<9>, mega_fwd<10>, mega_fwd<11>,
                                mega_fwd<12>, mega_fwd<13>, mega_fwd<14>, mega_fwd<15>, mega_fwd<16>, mega_fwd<17>, mega_fwd<18>, mega_fwd<19>, mega_fwd<20>, mega_fwd<21>, mega_fwd<22>};
    for (int st = 0; st < 23; ++st) hipLaunchKernelGGL(fns[st], dim3(grid), dim3(NTHREADS), LDS_BYTES, stream, a);
#endif
}
```

```cpp
#include <hip/hip_runtime.h>
#include <hip/hip_cooperative_groups.h>
#include <cstdio>
#include <cstdint>
namespace cg = cooperative_groups;
namespace pg8 {
#define PG8_LAS __attribute__((address_space(3)))
typedef unsigned short bf16_t;
typedef short bf16x8 __attribute__((ext_vector_type(8)));
typedef float f32x4 __attribute__((ext_vector_type(4)));
typedef unsigned u32x4 __attribute__((ext_vector_type(4)));
constexpr int BM = 256, BK = 64, HALF = 128, HTB = HALF * BK * 2  , STAGE_BYTES = 8 * HTB, NXCD = 8, WGM = 8;

__host__ __device__ __forceinline__ int lds_byte(int r, int c) { const int st = (r >> 4) * 2 + (c >> 5), rr = r & 15, cc = c & 31, ob = rr * 64 + cc * 2; return st * 1024 + (ob ^ (((ob >> 9) & 1) << 5)); }
__host__ __device__ __forceinline__ void stage_rc(int b, int& R, int& C) { const int st = b / 1024, sb = b % 1024, swz = sb ^ (((sb >> 9) & 1) << 5); R = (st >> 1) * 16 + swz / 64; C = (st & 1) * 32 + (swz % 64) / 2; }
__host__ __device__ __forceinline__ int perm32(int rho) { const int n = rho >> 4, i = rho & 15; return 8 * (i >> 2) + 4 * n + (i & 3); }

struct Unit { int pm, pn; };
struct Gemm { const bf16_t* A; const bf16_t* Bt; int M, N, K; };

struct StaticOrder {
    int nM, nN, nwg, G, c;
    __host__ __device__ void init(int M, int N, int G_, int c_) { nM = M / BM; nN = N / BM; nwg = nM * nN; G = G_; c = c_; }
    __host__ __device__ bool next(int i, Unit& u) const {
        const long L = (long)i * G + c; if (L >= nwg) return false;
        int wgid = (int)L; { const int q = nwg / NXCD, r = nwg % NXCD, xcd = wgid % NXCD, off = wgid / NXCD; wgid = (xcd < r ? xcd * (q + 1) : r * (q + 1) + (xcd - r) * q) + off; }
        const int nig = WGM * nN, gid = wgid / nig, fm = gid * WGM, gsz = (nM - fm) < WGM ? (nM - fm) : WGM;
        u.pm = fm + ((wgid % nig) % gsz); u.pn = (wgid % nig) / gsz; return true;
    }
    __device__ __forceinline__ void a_ready(const Unit&) const {}
    __device__ __forceinline__ void done(const Unit&) const {}
};


constexpr int DM = 1024, NBATCH = 16, SEQ = 2048, DBATCH = 8, DSEQ = 32;
constexpr int MP = NBATCH * SEQ, MS = DBATCH * DSEQ, MT = MP + MS;
constexpr int DFF = 2816, KCACHE = 512, KS_ROWS = KCACHE + DSEQ;
constexpr size_t O_YP = 0, O_YS = (size_t)MP * DM, O_POOLP = O_YS + (size_t)MS * DM, O_KP = O_POOLP + 2 * 16 * 15 * 512,
                 O_VP = O_KP + (size_t)2 * 16 * 512 * 512, O_CONVP = O_VP + (size_t)2 * 16 * 512 * 512, O_POOLS = O_CONVP + 2 * 16 * 2 * 2816,
                 O_KS = O_POOLS + 2 * 8 * 15 * 512, O_VS = O_KS + 2 * 8 * 32 * 512, O_CONVS = O_VS + 2 * 8 * 32 * 512, O_END = O_CONVS + 2 * 8 * 2 * 2816;

constexpr size_t MiB = 1u << 20;
constexpr size_t WL_IN = 0, WL_C = 8 * MiB, WL_AP = 9 * MiB, WL_OUT = 10 * MiB, WL_UP = 12 * MiB, WL_DOWN = 23 * MiB, WL_PLE = 29 * MiB  , WL_PG = 30 * MiB, WL_SIZE = 32 * MiB;
static_assert(WL_DOWN + (size_t)1024 * 2816 * 2 <= WL_PLE && WL_UP + (size_t)5632 * 1024 * 2 <= WL_DOWN, "weights map");
constexpr size_t WS_W = 1 * MiB;
constexpr size_t WS_HB = WS_W + 2 * WL_SIZE;
constexpr size_t WS_R = WS_HB + 65 * MiB;
constexpr size_t R_U = 0, R_Q = 33 * MiB, R_K = 66 * MiB, R_VT = 99 * MiB, R_G = 131 * MiB, R_D = 260 * MiB, R_KS = 293 * MiB, R_VTS = 298 * MiB;
constexpr size_t R_A = 0, R_ACT = 178 * MiB;
constexpr size_t R_PB = 0, R_T = 17 * MiB, R_HB3 = 82 * MiB;
constexpr size_t R_STG = 303 * MiB, R_STG2 = 357 * MiB;
constexpr size_t R_MG = 303 * MiB;
constexpr size_t WS_END = WS_R + 368 * MiB;
static_assert((size_t)MT * 2816 * 2 <= 178 * MiB && (size_t)MT * 2048 * 2 <= 129 * MiB && (size_t)MT * 512 * 2 <= 33 * MiB && (size_t)MT * 1024 * 2 <= 65 * MiB, "ws map");
static_assert(WS_END <= 512 * MiB, "ws budget");

constexpr size_t S_POOLP = 0, S_KP = 16 * 15 * 512, S_VP = S_KP + (size_t)16 * 512 * 512, S_POOLS = S_VP + (size_t)16 * 512 * 512, S_KS = S_POOLS + 8 * 15 * 512, S_VS = S_KS + 8 * 32 * 512, S_END = S_VS + 8 * 32 * 512;
constexpr size_t S_CONVP = 0, S_CONVS = 16 * 2 * 2816, S_CEND = S_CONVS + 8 * 2 * 2816;
typedef float f32x2 __attribute__((ext_vector_type(2)));
__device__ __forceinline__ unsigned cvt_pk_bf16(float lo, float hi) { unsigned r; asm volatile("v_cvt_pk_bf16_f32 %0, %1, %2" : "=v"(r) : "v"(lo), "v"(hi)); return r; }
__device__ __forceinline__ float bflo(unsigned u) { return __uint_as_float(u << 16); }
__device__ __forceinline__ float bfhi(unsigned u) { return __uint_as_float(u & 0xffff0000u); }
__device__ __forceinline__ float sigmoidf_(float x) { return __builtin_amdgcn_rcpf(1.0f + __builtin_amdgcn_exp2f(-1.4426950408889634f * x)); }
__device__ __forceinline__ float gelu_tanh(float x) { const float u = 1.5957691216057308f * x * (1.0f + 0.044715f * x * x); return x * sigmoidf_(u); }
__device__ __forceinline__ u32x4 pack8(const f32x4 a, const f32x4 b) { u32x4 w; w.x = cvt_pk_bf16(a[0], a[1]); w.y = cvt_pk_bf16(a[2], a[3]); w.z = cvt_pk_bf16(b[0], b[1]); w.w = cvt_pk_bf16(b[2], b[3]); return w; }
__device__ __forceinline__ void unpack8(const u32x4 w, f32x4& a, f32x4& b) { a = (f32x4){bflo(w.x), bfhi(w.x), bflo(w.y), bfhi(w.y)}; b = (f32x4){bflo(w.z), bfhi(w.z), bflo(w.w), bfhi(w.w)}; }

#define EPI_LOOP_BEGIN asm volatile("" : "+v"(fr), "+v"(fq));     \
    _Pragma("unroll") for (int ai = 0; ai < 2; ++ai) _Pragma("unroll") for (int m = 0; m < 4; ++m) { const int row = u.pm * BM + ai * HALF + wr * 64 + m * 16 + fr; \
    _Pragma("unroll") for (int bj = 0; bj < 2; ++bj) { const int c = u.pn * BM + bj * HALF + wc * 32 + 8 * fq; f32x4 v0 = acc[ai][bj][m][0], v1 = acc[ai][bj][m][1];
#define EPI_LOOP_END } asm volatile("" ::: "memory"); }

struct EpiG1 {
    static constexpr bool PERM = true, AFTER_DRAIN = false;
    unsigned char* wsb; const float* bgate; int layer; float* dout;
    __device__ __forceinline__ void operator()(const f32x4 (&acc)[2][2][4][2], const Unit& u, int wr, int wc, int fr, int fq) const {
        const int kind = u.pn < 8 ? (u.pn >> 1) : 4; const bool samp = u.pm >= MP / BM;
        unsigned char* wsb = this->wsb; asm volatile("" : "+s"(wsb));
        bf16_t* const U = (bf16_t*)(wsb + WS_R + R_U); bf16_t* const Q = (bf16_t*)(wsb + WS_R + R_Q); bf16_t* const Kp = (bf16_t*)(wsb + WS_R + R_K); bf16_t* const Vtp = (bf16_t*)(wsb + WS_R + R_VT);
        bf16_t* const Ks = (bf16_t*)(wsb + WS_R + R_KS); bf16_t* const Vts = (bf16_t*)(wsb + WS_R + R_VTS); bf16_t* const G = (bf16_t*)(wsb + WS_R + R_G);
        EPI_LOOP_BEGIN
            int b, t; if (samp) { const int rs = row - MP; b = rs >> 5; t = rs & 31; } else { b = row >> 11; t = row & 2047; }
            if (kind == 0) {
                *(u32x4*)(U + (size_t)row * 512 + c) = pack8(v0, v1);
                if (!samp) { if (t >= SEQ - 15) { float* o = dout + O_POOLP + (size_t)layer * (16 * 15 * 512) + ((size_t)b * 15 + (t - (SEQ - 15))) * 512 + c; *(f32x4*)o = v0; *(f32x4*)(o + 4) = v1; } }
                else { if (t >= DSEQ - 15) { float* o = dout + O_POOLS + (size_t)layer * (8 * 15 * 512) + ((size_t)b * 15 + (t - (DSEQ - 15))) * 512 + c; *(f32x4*)o = v0; *(f32x4*)(o + 4) = v1; } }
            } else if (kind == 1) {
                *(u32x4*)(Q + (size_t)row * 512 + (c - 512)) = pack8(v0 * 0.125f, v1 * 0.125f);
            } else if (kind == 2) {
                const int ck = c - 1024;
                if (!samp) { *(u32x4*)(Kp + (size_t)row * 512 + ck) = pack8(v0, v1);
                    if (t >= SEQ - 512) { float* o = dout + O_KP + (size_t)layer * (16 * 512 * 512) + ((size_t)b * 512 + (t - (SEQ - 512))) * 512 + ck; *(f32x4*)o = v0; *(f32x4*)(o + 4) = v1; } }
                else { *(u32x4*)(Ks + ((size_t)b * KS_ROWS + KCACHE + t) * 512 + ck) = pack8(v0, v1);
                    float* o = dout + O_KS + (size_t)layer * (8 * 32 * 512) + ((size_t)b * 32 + t) * 512 + ck; *(f32x4*)o = v0; *(f32x4*)(o + 4) = v1; }
            } else if (kind == 3) {
                const int cv = c - 1536, h = cv >> 6, d0 = cv & 63; const u32x4 w = pack8(v0, v1);
                bf16_t* vb; size_t pitch;
                if (!samp) { vb = Vtp + ((size_t)(b * 8 + h) * 64 + d0) * SEQ + t; pitch = SEQ;
                    if (t >= SEQ - 512) { float* o = dout + O_VP + (size_t)layer * (16 * 512 * 512) + ((size_t)b * 512 + (t - (SEQ - 512))) * 512 + cv; *(f32x4*)o = v0; *(f32x4*)(o + 4) = v1; } }
                else { vb = Vts + ((size_t)(b * 8 + h) * 64 + d0) * KS_ROWS + KCACHE + t; pitch = KS_ROWS;
                    float* o = dout + O_VS + (size_t)layer * (8 * 32 * 512) + ((size_t)b * 32 + t) * 512 + cv; *(f32x4*)o = v0; *(f32x4*)(o + 4) = v1; }
                vb[0 * pitch] = (bf16_t)(w.x & 0xffffu); vb[1 * pitch] = (bf16_t)(w.x >> 16); vb[2 * pitch] = (bf16_t)(w.y & 0xffffu); vb[3 * pitch] = (bf16_t)(w.y >> 16);
                vb[4 * pitch] = (bf16_t)(w.z & 0xffffu); vb[5 * pitch] = (bf16_t)(w.z >> 16); vb[6 * pitch] = (bf16_t)(w.w & 0xffffu); vb[7 * pitch] = (bf16_t)(w.w >> 16);
            } else {
                const int cgt = c - 2048; const f32x4 b0 = *(const f32x4*)(bgate + cgt), b1 = *(const f32x4*)(bgate + cgt + 4);
                v0 = v0 + b0; v1 = v1 + b1;
                _Pragma("unroll") for (int j = 0; j < 4; ++j) { v0[j] = sigmoidf_(v0[j]); v1[j] = sigmoidf_(v1[j]); }
                *(u32x4*)(G + (size_t)row * 2048 + cgt) = pack8(v0, v1);
            }
        EPI_LOOP_END
    }
};
template <int MODE> struct EpiGate {
    static constexpr bool PERM = true, AFTER_DRAIN = false;
    bf16_t* O; int ldc; const bf16_t* G; int goff;
    __device__ __forceinline__ void operator()(const f32x4 (&acc)[2][2][4][2], const Unit& u, int wr, int wc, int fr, int fq) const {
        EPI_LOOP_BEGIN
            bf16_t* op = O + (size_t)row * ldc + c;
            if (MODE >= 1) { f32x4 g0, g1; unpack8(*(const u32x4*)(G + (size_t)row * 2048 + goff + c), g0, g1); v0 = v0 * g0; v1 = v1 * g1; }
            if (MODE == 2) { f32x4 p0, p1; unpack8(*(const u32x4*)op, p0, p1); v0 = v0 + p0; v1 = v1 + p1; }
            *(u32x4*)op = pack8(v0, v1);
        EPI_LOOP_END
    }
};
struct EpiRes {
    static constexpr bool PERM = true, AFTER_DRAIN = false;
    const float* bp; const float* bs; float* X;
    __device__ __forceinline__ void operator()(const f32x4 (&acc)[2][2][4][2], const Unit& u, int wr, int wc, int fr, int fq) const {
        const float* base = u.pm >= MP / BM ? bs - (size_t)MP * DM : bp;
        asm volatile("" : "+v"(fr), "+v"(fq));
        const size_t off0 = (size_t)(u.pm * BM + wr * 64 + fr) * DM + u.pn * BM + wc * 32 + 8 * fq;
        f32x4 cur[2][2], nxt[2][2];
#pragma unroll
        for (int bj = 0; bj < 2; ++bj) { cur[bj][0] = *(const f32x4*)(base + off0 + bj * HALF); cur[bj][1] = *(const f32x4*)(base + off0 + bj * HALF + 4); }
#pragma unroll
        for (int it = 0; it < 8; ++it) { const int ai = it >> 2, m = it & 3; const size_t off = off0 + (size_t)(ai * HALF + m * 16) * DM;
            if (it < 7) { const size_t offn = off0 + (size_t)(((it + 1) >> 2) * HALF + ((it + 1) & 3) * 16) * DM;
#pragma unroll
                for (int bj = 0; bj < 2; ++bj) { nxt[bj][0] = *(const f32x4*)(base + offn + bj * HALF); nxt[bj][1] = *(const f32x4*)(base + offn + bj * HALF + 4); } }
#pragma unroll
            for (int bj = 0; bj < 2; ++bj) { *(f32x4*)(X + off + bj * HALF) = cur[bj][0] + acc[ai][bj][m][0]; *(f32x4*)(X + off + bj * HALF + 4) = cur[bj][1] + acc[ai][bj][m][1]; }
#pragma unroll
            for (int bj = 0; bj < 2; ++bj) { cur[bj][0] = nxt[bj][0]; cur[bj][1] = nxt[bj][1]; }
            asm volatile("" ::: "memory"); }
    }
};
struct EpiPle {
    static constexpr bool PERM = true, AFTER_DRAIN = false;
    const bf16_t* T; float* X;
    __device__ __forceinline__ void operator()(const f32x4 (&acc)[2][2][4][2], const Unit& u, int wr, int wc, int fr, int fq) const {
        EPI_LOOP_BEGIN
            const size_t off = (size_t)row * DM + c; f32x4 t0, t1; unpack8(*(const u32x4*)(T + off), t0, t1);
            f32x4 x0 = *(const f32x4*)(X + off), x1 = *(const f32x4*)(X + off + 4);
            _Pragma("unroll") for (int j = 0; j < 4; ++j) { x0[j] += t0[j] * sigmoidf_(v0[j]); x1[j] += t1[j] * sigmoidf_(v1[j]); }
            *(f32x4*)(X + off) = x0; *(f32x4*)(X + off + 4) = x1;
        EPI_LOOP_END
    }
};
struct EpiUpA {
    static constexpr bool PERM = true, AFTER_DRAIN = false;
    bf16_t* A; float* out; int layer;
    __device__ __forceinline__ void operator()(const f32x4 (&acc)[2][2][4][2], const Unit& u, int wr, int wc, int fr, int fq) const {
        const bool samp = u.pm >= MP / BM;
        EPI_LOOP_BEGIN
            *(u32x4*)(A + (size_t)row * DFF + c) = pack8(v0, v1);
            if (!samp) { const int b = row >> 11, t = row & 2047; if (t >= SEQ - 2) { float* o = out + O_CONVP + (size_t)layer * (16 * 2 * 2816) + ((size_t)b * 2 + (t - (SEQ - 2))) * DFF + c; *(f32x4*)o = v0; *(f32x4*)(o + 4) = v1; } }
            else { const int rs = row - MP, b = rs >> 5, t = rs & 31; if (t >= DSEQ - 2) { float* o = out + O_CONVS + (size_t)layer * (8 * 2 * 2816) + ((size_t)b * 2 + (t - (DSEQ - 2))) * DFF + c; *(f32x4*)o = v0; *(f32x4*)(o + 4) = v1; } }
        EPI_LOOP_END
    }
};
struct EpiUpB {
    static constexpr bool PERM = true, AFTER_DRAIN = false;
    const bf16_t* A; bf16_t* ACT; const float* wdw; const float* bdw; const float* cconv;
    __device__ __forceinline__ void operator()(const f32x4 (&acc)[2][2][4][2], const Unit& u, int wr, int wc, int fr, int fq) const {
        const bool samp = u.pm >= MP / BM;
        EPI_LOOP_BEGIN
            int b, t; if (samp) { const int rs = row - MP; b = rs >> 5; t = rs & 31; } else { b = row >> 11; t = row & 2047; }
            const bf16_t* ap = A + (size_t)row * DFF + c;
            f32x4 a00, a01, a10, a11, a20, a21;
            unpack8(*(const u32x4*)ap, a00, a01);
            if (t >= 1) unpack8(*(const u32x4*)(ap - DFF), a10, a11);
            else if (samp) { const float* cp = cconv + ((size_t)b * 2 + 1) * DFF + c; a10 = *(const f32x4*)cp; a11 = *(const f32x4*)(cp + 4); }
            else { a10 = (f32x4){0.f, 0.f, 0.f, 0.f}; a11 = a10; }
            if (t >= 2) unpack8(*(const u32x4*)(ap - 2 * DFF), a20, a21);
            else if (samp) { const float* cp = cconv + ((size_t)b * 2 + t) * DFF + c; a20 = *(const f32x4*)cp; a21 = *(const f32x4*)(cp + 4); }
            else { a20 = (f32x4){0.f, 0.f, 0.f, 0.f}; a21 = a20; }
            const f32x4 w00 = *(const f32x4*)(wdw + c), w01 = *(const f32x4*)(wdw + c + 4), w10 = *(const f32x4*)(wdw + DFF + c), w11 = *(const f32x4*)(wdw + DFF + c + 4),
                        w20 = *(const f32x4*)(wdw + 2 * DFF + c), w21 = *(const f32x4*)(wdw + 2 * DFF + c + 4), bb0 = *(const f32x4*)(bdw + c), bb1 = *(const f32x4*)(bdw + c + 4);
            f32x4 s0 = bb0 + w00 * a20 + w10 * a10 + w20 * a00, s1 = bb1 + w01 * a21 + w11 * a11 + w21 * a01;
            _Pragma("unroll") for (int j = 0; j < 4; ++j) { s0[j] = gelu_tanh(s0[j]) * v0[j]; s1[j] = gelu_tanh(s1[j]) * v1[j]; }
            *(u32x4*)(ACT + (size_t)row * DFF + c) = pack8(s0, s1);
        EPI_LOOP_END
    }
};

template <class Epi, class Sched, bool ALIGN_EPI = false, bool SP2 = false>
__device__ __forceinline__ void gemm_phase(PG8_LAS unsigned char* lds, const Gemm g, const Sched& S, const Epi& E) {
    int tid_ = threadIdx.x; asm volatile("" : "+v"(tid_));
    const int tid = tid_, wid = __builtin_amdgcn_readfirstlane(tid >> 6), lane = tid & 63, wr = wid >> 2, wc = wid & 3, fr = lane & 15, fq = lane >> 4;
    int K_ = g.K; if (g.K < 512) asm volatile("" : "+s"(K_));
    const int K = K_, nt = K / BK;
    unsigned voffA[2], voffB[2];
#pragma unroll
    for (int i = 0; i < 2; ++i) { int R, C; stage_rc(tid * 16 + i * 8192, R, C); const int Rb = Epi::PERM ? ((R & ~31) + perm32(R & 31)) : R;
        voffA[i] = (unsigned)(R * K + C) * 2u; voffB[i] = (unsigned)(Rb * K + C) * 2u; }
    const size_t kstep = (size_t)(BK * 2);
    const size_t hstep = (size_t)HALF * K * 2;
    const size_t tstep = 2 * hstep;
    const unsigned ldsw = (unsigned)wid * 1024u;
    const int aoff = lds_byte(wr * 64 + fr, fq * 8), boff = lds_byte(wc * 32 + fr, fq * 8);
#define PG8_SA(b, h) (((b) * 2 + (h)) * HTB)
#define PG8_SB(b, h) ((4 + (b) * 2 + (h)) * HTB)
#define PG8_STAGE(bufoff, gbase, voff) do { _Pragma("unroll") for (int _i = 0; _i < 2; ++_i) \
        __builtin_amdgcn_global_load_lds((const unsigned*)((const char*)(gbase) + (voff)[_i]), (PG8_LAS unsigned*)(lds + (bufoff) + ldsw + _i * 8192), 16, 0, 0); } while (0)
#define PG8_LDA(dst, b, h) do { _Pragma("unroll") for (int m = 0; m < 4; ++m) _Pragma("unroll") for (int k = 0; k < 2; ++k) dst[m][k] = *(const PG8_LAS bf16x8*)(lds + PG8_SA(b, h) + aoff + m * 2048 + k * 1024); } while (0)
#define PG8_LDB(dst, b, h) do { _Pragma("unroll") for (int n = 0; n < 2; ++n) _Pragma("unroll") for (int k = 0; k < 2; ++k) dst[n][k] = *(const PG8_LAS bf16x8*)(lds + PG8_SB(b, h) + boff + n * 2048 + k * 1024); } while (0)
#define PG8_MMA(ai, bj, At, Bt) do { __builtin_amdgcn_s_setprio(1); _Pragma("unroll") for (int m = 0; m < 4; ++m) _Pragma("unroll") for (int n = 0; n < 2; ++n) _Pragma("unroll") for (int k = 0; k < 2; ++k) \
        acc[ai][bj][m][n] = __builtin_amdgcn_mfma_f32_16x16x32_bf16(Bt[n][k], At[m][k], acc[ai][bj][m][n], 0, 0, 0); __builtin_amdgcn_s_setprio(0); } while (0)
#define PG8_WAIT_V(n) asm volatile("s_waitcnt vmcnt(" #n ")" ::: "memory")
#define PG8_WAIT_L(n) asm volatile("s_waitcnt lgkmcnt(" #n ")" ::: "memory")
#define PG8_BAR __builtin_amdgcn_s_barrier()
#define PG8_SCHED __builtin_amdgcn_sched_barrier(0)
    Unit cur, nxt; int ui = 0;
    if (!S.next(0, cur)) return;
    f32x4 acc[2][2][4][2];
#pragma unroll
    for (int a = 0; a < 2; ++a)
#pragma unroll
        for (int b = 0; b < 2; ++b)
#pragma unroll
            for (int m = 0; m < 4; ++m)
#pragma unroll
                for (int n = 0; n < 2; ++n) acc[a][b][m][n] = (f32x4){0.f, 0.f, 0.f, 0.f};
    bf16x8 At[4][2], B0[2][2], B1[2][2];
    const char* cA = (const char*)g.A + (size_t)cur.pm * tstep; const char* cB = (const char*)g.Bt + (size_t)cur.pn * tstep;
    S.a_ready(cur);
    if constexpr (SP2) {
        PG8_STAGE(PG8_SB(0, 0), cB, voffB); PG8_STAGE(PG8_SB(0, 1), cB + hstep, voffB); PG8_STAGE(PG8_SA(0, 0), cA, voffA); PG8_STAGE(PG8_SA(0, 1), cA + hstep, voffA);
        if (wr == 1) PG8_BAR;
        PG8_WAIT_V(2); PG8_BAR;
        PG8_STAGE(PG8_SB(1, 0), cB + kstep, voffB); PG8_STAGE(PG8_SA(1, 0), cA + kstep, voffA); PG8_STAGE(PG8_SB(1, 1), cB + hstep + kstep, voffB);
        PG8_WAIT_V(6); PG8_BAR;
    } else {
        PG8_STAGE(PG8_SB(0, 0), cB, voffB); PG8_STAGE(PG8_SA(0, 0), cA, voffA); PG8_STAGE(PG8_SB(0, 1), cB + hstep, voffB); PG8_STAGE(PG8_SA(0, 1), cA + hstep, voffA);
        if (wr == 1) PG8_BAR;
        PG8_WAIT_V(4); PG8_BAR;
        PG8_STAGE(PG8_SB(1, 0), cB + kstep, voffB); PG8_STAGE(PG8_SA(1, 0), cA + kstep, voffA); PG8_STAGE(PG8_SB(1, 1), cB + hstep + kstep, voffB);
        PG8_WAIT_V(6); PG8_BAR;
    }
    for (;;) {
        const bool has_next = S.next(ui + 1, nxt);
        const char* nA = has_next ? (const char*)g.A + (size_t)nxt.pm * tstep : cA; const char* nB = has_next ? (const char*)g.Bt + (size_t)nxt.pn * tstep : cB;
        for (int t = 0; t < nt; t += 2) {
            const bool last = (t == nt - 2);
            const char* a1 = cA + (size_t)(t + 1) * kstep;
            const char* a2 = last ? nA : cA + (size_t)(t + 2) * kstep; const char* b2 = last ? nB : cB + (size_t)(t + 2) * kstep;
            const char* a3 = a2 + kstep; const char* b3 = b2 + kstep;
            if (last && has_next) S.a_ready(nxt);
            if constexpr (SP2) {
            PG8_LDB(B0, 0, 0); PG8_LDB(B1, 0, 1); PG8_SCHED; PG8_LDA(At, 0, 0); PG8_STAGE(PG8_SA(1, 1), a1 + hstep, voffA);
            PG8_WAIT_V(8); PG8_WAIT_L(0); PG8_BAR; PG8_MMA(0, 0, At, B0); PG8_MMA(0, 1, At, B1); PG8_BAR; PG8_SCHED;
            PG8_LDA(At, 0, 1); PG8_STAGE(PG8_SB(0, 0), b2, voffB); PG8_STAGE(PG8_SB(0, 1), b2 + hstep, voffB); PG8_STAGE(PG8_SA(0, 0), a2, voffA);
            PG8_WAIT_V(8); PG8_WAIT_L(0); PG8_BAR; PG8_MMA(1, 0, At, B0); PG8_MMA(1, 1, At, B1); PG8_BAR; PG8_SCHED;
            PG8_LDB(B0, 1, 0); PG8_LDB(B1, 1, 1); PG8_SCHED; PG8_LDA(At, 1, 0); PG8_STAGE(PG8_SA(0, 1), a2 + hstep, voffA);
            PG8_WAIT_V(8); PG8_WAIT_L(0); PG8_BAR; PG8_MMA(0, 0, At, B0); PG8_MMA(0, 1, At, B1); PG8_BAR; PG8_SCHED;
            PG8_LDA(At, 1, 1); PG8_STAGE(PG8_SB(1, 0), b3, voffB); PG8_STAGE(PG8_SB(1, 1), b3 + hstep, voffB); PG8_STAGE(PG8_SA(1, 0), a3, voffA);
            PG8_WAIT_V(8); PG8_WAIT_L(0); PG8_BAR; PG8_MMA(1, 0, At, B0); PG8_MMA(1, 1, At, B1); PG8_BAR; PG8_SCHED;
            } else {
            PG8_LDB(B0, 0, 0); PG8_SCHED; PG8_LDA(At, 0, 0); PG8_STAGE(PG8_SA(1, 1), a1 + hstep, voffA);
            PG8_WAIT_L(8); PG8_BAR; PG8_WAIT_L(0); PG8_MMA(0, 0, At, B0); PG8_BAR; PG8_SCHED;
            PG8_LDB(B1, 0, 1); PG8_STAGE(PG8_SB(0, 0), b2, voffB);
            PG8_BAR; PG8_WAIT_L(0); PG8_MMA(0, 1, At, B1); PG8_BAR;
            PG8_LDA(At, 0, 1); PG8_STAGE(PG8_SA(0, 0), a2, voffA);
            PG8_BAR; PG8_WAIT_L(0); PG8_MMA(1, 0, At, B0); PG8_BAR; PG8_SCHED;
            PG8_STAGE(PG8_SB(0, 1), b2 + hstep, voffB);
            PG8_WAIT_V(6); PG8_BAR; PG8_MMA(1, 1, At, B1); PG8_BAR;
            PG8_LDB(B0, 1, 0); PG8_SCHED; PG8_LDA(At, 1, 0); PG8_STAGE(PG8_SA(0, 1), a2 + hstep, voffA);
            PG8_WAIT_L(8); PG8_BAR; PG8_WAIT_L(0); PG8_MMA(0, 0, At, B0); PG8_BAR; PG8_SCHED;
            PG8_LDB(B1, 1, 1); PG8_STAGE(PG8_SB(1, 0), b3, voffB);
            PG8_BAR; PG8_WAIT_L(0); PG8_MMA(0, 1, At, B1); PG8_BAR;
            PG8_LDA(At, 1, 1); PG8_STAGE(PG8_SA(1, 0), a3, voffA);
            PG8_BAR; PG8_WAIT_L(0); PG8_MMA(1, 0, At, B0); PG8_BAR; PG8_SCHED;
            PG8_STAGE(PG8_SB(1, 1), b3 + hstep, voffB);
            PG8_WAIT_V(6); PG8_BAR; PG8_MMA(1, 1, At, B1); PG8_BAR;
            }
        }
        if constexpr (ALIGN_EPI) { if (wr == 0) PG8_BAR; }
        if constexpr (!Epi::AFTER_DRAIN) { E(acc, cur, wr, wc, fr, fq); S.done(cur); }
        if (!has_next) break;
#pragma unroll
        for (int a = 0; a < 2; ++a)
#pragma unroll
            for (int b = 0; b < 2; ++b)
#pragma unroll
                for (int m = 0; m < 4; ++m)
#pragma unroll
                    for (int n = 0; n < 2; ++n) acc[a][b][m][n] = (f32x4){0.f, 0.f, 0.f, 0.f};
        cur = nxt; cA = nA; cB = nB; ++ui;
        if constexpr (ALIGN_EPI) { if (wr == 1) PG8_BAR; }
    }
    PG8_WAIT_V(0);
    if constexpr (!ALIGN_EPI) { if (wr == 0) PG8_BAR; }
    PG8_BAR;
    if constexpr (Epi::AFTER_DRAIN) { E.fused(acc, cur, wr, wc, fr, fq, lds, wid, lane); S.done(cur); }
#undef PG8_SA
#undef PG8_SB
#undef PG8_STAGE
#undef PG8_LDA
#undef PG8_LDB
#undef PG8_MMA
#undef PG8_WAIT_V
#undef PG8_WAIT_L
#undef PG8_BAR
#undef PG8_SCHED
}
}
using namespace pg8;
#define LAS __attribute__((address_space(3)))
typedef float f32x16 __attribute__((ext_vector_type(16)));
typedef short s16x4 __attribute__((ext_vector_type(4)));
typedef __bf16 bf16x2_t __attribute__((ext_vector_type(2)));

#ifndef ONE_LAUNCH
#define ONE_LAUNCH 1
#endif
constexpr int NWAVES = 8, NTHREADS = 512;
constexpr int LDS_BYTES = 147456;
constexpr float LOG2E = 1.4426950408889634f;
constexpr float EPS = 1e-6f;

struct Args { const float* in[26]; float* p_out; unsigned char* p_ws; };

__device__ __forceinline__ float shx(float v, int o, int lane) { return __int_as_float(__builtin_amdgcn_ds_bpermute((lane ^ o) << 2, __float_as_int(v))); }
__device__ __forceinline__ float wave_sum(float v, int lane) {
#pragma unroll
    for (int o = 1; o < 64; o <<= 1) v += shx(v, o, lane);
    return v;
}
__device__ __forceinline__ unsigned f2bf(float f) { unsigned u = __builtin_bit_cast(unsigned, f); return (u + 0x7fffu + ((u >> 16) & 1u)) >> 16; }
__device__ __forceinline__ unsigned pk2(float lo, float hi) { return f2bf(lo) | (f2bf(hi) << 16); }

__device__ __forceinline__ void transpose_item(const float* W, int K, int N, bf16_t* WT, LAS float* scr, int item, int lane) {
    const int nblk = N / 32, kb = item / nblk, nb = item % nblk, k0 = 64 * kb, n0 = 32 * nb;
#pragma unroll
    for (int i = 0; i < 32; ++i) { const int kk = 2 * i + (lane >> 5); scr[kk * 33 + (lane & 31)] = W[(size_t)(k0 + kk) * N + n0 + (lane & 31)]; }
    asm volatile("s_waitcnt lgkmcnt(0)" ::: "memory");
    const int c = lane & 7;
#pragma unroll
    for (int j = 0; j < 4; ++j) { const int n = (lane >> 3) + 8 * j; const LAS float* s = scr + (8 * c) * 33 + n;
        u32x4 o; o.x = pk2(s[0 * 33], s[1 * 33]); o.y = pk2(s[2 * 33], s[3 * 33]); o.z = pk2(s[4 * 33], s[5 * 33]); o.w = pk2(s[6 * 33], s[7 * 33]);
        *(u32x4*)(WT + (size_t)(n0 + n) * K + k0 + 8 * c) = o; }
    asm volatile("s_waitcnt lgkmcnt(0)" ::: "memory");
}

__device__ __forceinline__ void fold_item(const float* wgrp, const float* scale, const float* wpp, bf16_t* WcT, int item, int lane) {
    const int kb = item >> 2, nc = item & 3, k0 = kb * 8, g = k0 >> 7, n0 = nc * 256 + lane * 4;
    f32x4 acc[8];
#pragma unroll
    for (int i = 0; i < 8; ++i) acc[i] = (f32x4){0.f, 0.f, 0.f, 0.f};
#pragma unroll 8
    for (int d = 0; d < 128; ++d) {
        const f32x4 w = *(const f32x4*)(wpp + (size_t)(g * 128 + d) * 1024 + n0) * scale[g * 128 + d];
#pragma unroll
        for (int i = 0; i < 8; ++i) acc[i] += w * wgrp[(size_t)(k0 + i) * 128 + d];
    }
#pragma unroll
    for (int j = 0; j < 4; ++j) { u32x4 o; o.x = pk2(acc[0][j], acc[1][j]); o.y = pk2(acc[2][j], acc[3][j]); o.z = pk2(acc[4][j], acc[5][j]); o.w = pk2(acc[6][j], acc[7][j]);
        *(u32x4*)(WcT + (size_t)(n0 + j) * 512 + k0) = o; }
}

__device__ __forceinline__ void norm_rows_bf16(const float* xp, const float* xs, const float* g, bf16_t* HB, int gw, int ngw, int lane) {
    f32x4 gv[4];
#pragma unroll
    for (int j = 0; j < 4; ++j) gv[j] = ((const f32x4*)g)[lane + 64 * j];
    f32x4 nx[4];
    if (gw < MT) { const f32x4* xr = (const f32x4*)(gw < MP ? xp + (size_t)gw * DM : xs + (size_t)(gw - MP) * DM) + lane;
#pragma unroll
        for (int j = 0; j < 4; ++j) nx[j] = xr[64 * j]; }
    for (int m = gw; m < MT; m += ngw) {
        f32x4 v[4]; float s = 0.f;
#pragma unroll
        for (int j = 0; j < 4; ++j) v[j] = nx[j];
        const int mn = m + ngw;
        if (mn < MT) { const f32x4* xr = (const f32x4*)(mn < MP ? xp + (size_t)mn * DM : xs + (size_t)(mn - MP) * DM) + lane;
#pragma unroll
            for (int j = 0; j < 4; ++j) nx[j] = xr[64 * j]; }
#pragma unroll
        for (int j = 0; j < 4; ++j) s += (v[j].x * v[j].x + v[j].y * v[j].y) + (v[j].z * v[j].z + v[j].w * v[j].w);
        const float r = 1.0f / sqrtf(wave_sum(s, lane) * (1.0f / DM) + EPS);
        unsigned long long* o8 = (unsigned long long*)(HB + (size_t)m * DM) + lane;
#pragma unroll
        for (int j = 0; j < 4; ++j) { const f32x4 y = v[j] * r * gv[j]; o8[64 * j] = (unsigned long long)pk2(y.x, y.y) | ((unsigned long long)pk2(y.z, y.w) << 32); }
    }
}
__device__ __forceinline__ void norm_rows_f32(float* X, const float* g, int gw, int ngw, int lane) {
    f32x4 gv[4];
#pragma unroll
    for (int j = 0; j < 4; ++j) gv[j] = ((const f32x4*)g)[lane + 64 * j];
    for (int m = gw; m < MT; m += ngw) {
        f32x4* xr = (f32x4*)(X + (size_t)m * DM) + lane;
        f32x4 v[4]; float s = 0.f;
#pragma unroll
        for (int j = 0; j < 4; ++j) { v[j] = xr[64 * j]; s += (v[j].x * v[j].x + v[j].y * v[j].y) + (v[j].z * v[j].z + v[j].w * v[j].w); }
        const float r = 1.0f / sqrtf(wave_sum(s, lane) * (1.0f / DM) + EPS);
#pragma unroll
        for (int j = 0; j < 4; ++j) xr[64 * j] = v[j] * r * gv[j];
    }
}

__device__ __forceinline__ bf16x8 pack_p(const f32x16& x, int s) {
    u32x4 p;
#pragma unroll
    for (int j = 0; j < 4; ++j) { f32x2 v = {x[8 * s + 2 * j], x[8 * s + 2 * j + 1]}; bf16x2_t b = __builtin_convertvector(v, bf16x2_t); p[j] = __builtin_bit_cast(unsigned, b); }
    return __builtin_bit_cast(bf16x8, p);
}

template <int NQ>
__device__ __forceinline__ void attn_unit(const bf16_t* Qp, const bf16_t* Kp, const bf16_t* Vtp, int vpitch, int kt0, int kt1, int dq0, const LAS float* tb, bf16_t* Op, int lane) {
    const int r = lane & 31, hi = lane >> 5;
    bf16x8 qf[NQ][4];
#pragma unroll
    for (int qi = 0; qi < NQ; ++qi)
#pragma unroll
        for (int s = 0; s < 4; ++s) qf[qi][s] = *(const bf16x8*)(Qp + (size_t)(32 * qi + r) * 512 + 32 * hi + 8 * s);
    f32x16 o[2][NQ]; float mrun[NQ], lrun[NQ];
#pragma unroll
    for (int qi = 0; qi < NQ; ++qi) { mrun[qi] = -1e30f; lrun[qi] = 0.f;
#pragma unroll
        for (int di = 0; di < 2; ++di)
#pragma unroll
            for (int i = 0; i < 16; ++i) o[di][qi][i] = 0.f; }
    const float bconst = tb[256];
    for (int kt = kt0; kt < kt1; ++kt) {
        const bf16_t* kp = Kp + ((long)(kt * 32 + r)) * 512 + 32 * hi;
        bf16x8 kf[4];
#pragma unroll
        for (int s = 0; s < 4; ++s) kf[s] = *(const bf16x8*)(kp + 8 * s);
        bf16x8 vf[2][2];
#pragma unroll
        for (int di = 0; di < 2; ++di)
#pragma unroll
            for (int ks = 0; ks < 2; ++ks) { const bf16_t* vp = Vtp + (long)(32 * di + r) * vpitch + kt * 32 + 16 * ks + 4 * hi;
                const s16x4 lo = *(const s16x4*)vp, hh = *(const s16x4*)(vp + 8); vf[di][ks] = __builtin_shufflevector(lo, hh, 0, 1, 2, 3, 4, 5, 6, 7); }
#pragma unroll
        for (int qi = 0; qi < NQ; ++qi) {
            f32x16 s;
#pragma unroll
            for (int i = 0; i < 16; ++i) s[i] = 0.f;
#pragma unroll
            for (int st = 0; st < 4; ++st) s = __builtin_amdgcn_mfma_f32_32x32x16_bf16(kf[st], qf[qi][st], s, 0, 0, 0);
            const int dmin = dq0 + 32 * qi - kt * 32 - 31;
            if (dmin >= 128) {
#pragma unroll
                for (int i = 0; i < 16; ++i) s[i] = s[i] * LOG2E + bconst;
            } else {
                const int dbase = dq0 + 32 * qi + r - kt * 32 - 4 * hi;
#pragma unroll
                for (int i = 0; i < 16; ++i) { int dd = dbase - ((i & 3) + 8 * (i >> 2)); dd = dd < -128 ? -128 : (dd > 128 ? 128 : dd); s[i] = s[i] * LOG2E + tb[dd + 128]; }
            }
            float mx = s[0];
#pragma unroll
            for (int i = 1; i < 16; ++i) mx = fmaxf(mx, s[i]);
            mx = fmaxf(mx, shx(mx, 32, lane));
            const float mn = fmaxf(mrun[qi], mx), alpha = __builtin_amdgcn_exp2f(mrun[qi] - mn); mrun[qi] = mn;
            float ps = 0.f;
#pragma unroll
            for (int i = 0; i < 16; ++i) { s[i] = __builtin_amdgcn_exp2f(s[i] - mn); ps += s[i]; }
            lrun[qi] = lrun[qi] * alpha + ps;
#pragma unroll
            for (int di = 0; di < 2; ++di)
#pragma unroll
                for (int i = 0; i < 16; ++i) o[di][qi][i] *= alpha;
#pragma unroll
            for (int ks = 0; ks < 2; ++ks) { const bf16x8 pf = pack_p(s, ks);
#pragma unroll
                for (int di = 0; di < 2; ++di) o[di][qi] = __builtin_amdgcn_mfma_f32_32x32x16_bf16(vf[di][ks], pf, o[di][qi], 0, 0, 0); }
        }
    }
#pragma unroll
    for (int qi = 0; qi < NQ; ++qi) {
        const float lt = lrun[qi] + shx(lrun[qi], 32, lane), inv = 1.0f / lt;
#pragma unroll
        for (int di = 0; di < 2; ++di)
#pragma unroll
            for (int g = 0; g < 4; ++g) {
                const unsigned lo = cvt_pk_bf16(o[di][qi][4 * g] * inv, o[di][qi][4 * g + 1] * inv), hh = cvt_pk_bf16(o[di][qi][4 * g + 2] * inv, o[di][qi][4 * g + 3] * inv);
                *(unsigned long long*)(Op + (size_t)(32 * qi + r) * 512 + 32 * di + 8 * g + 4 * hi) = (unsigned long long)lo | ((unsigned long long)hh << 32);
            }
    }
}

#define XB_TMO      128
#define XB_XCNT(j)  (256  + 64 * (j))
#define XB_XSUB(j)  (1280 + 64 * (j))
#define XB_XGEN(j)  (2304 + 64 * (j))
#define XB_TOP      3328
#define XB_TOPGEN   3392
#define XCD_BAR_WORDS 3456
#define XB_SPIN_CAP (1u << 18)

__device__ __forceinline__ unsigned xb_ld(unsigned* p)              { return __hip_atomic_load(p, __ATOMIC_RELAXED, __HIP_MEMORY_SCOPE_AGENT); }
__device__ __forceinline__ unsigned xb_add(unsigned* p, unsigned v) { return __hip_atomic_fetch_add(p, v, __ATOMIC_RELAXED, __HIP_MEMORY_SCOPE_AGENT); }
__device__ __forceinline__ unsigned xb_xcc_id() { return (unsigned)__builtin_amdgcn_s_getreg((3 << 11) | 20) & 0xFu; }
#define XB_SPIN(cond, bar) do { unsigned _sp = 0; while (cond) { __builtin_amdgcn_s_sleep(1); \
    if ((++_sp & 255u) == 0u) { if (xb_ld(&(bar)[XB_TMO])) break; if (_sp > XB_SPIN_CAP) { atomicAdd(&(bar)[XB_TMO], 1u); break; } } } } while (0)

struct XcdBarrier {
    unsigned* bar; unsigned x;
    volatile LAS unsigned* st;
};

__device__ __forceinline__ XcdBarrier xcd_barrier_post(unsigned* bar, volatile LAS unsigned* st) {
    XcdBarrier b; b.bar = bar; b.x = xb_xcc_id(); b.st = st;
    if (threadIdx.x == 0) (void)xb_add(&bar[XB_XCNT(b.x)], 1u);
    return b;
}
__device__ __forceinline__ void xcd_barrier_complete(unsigned* bar, unsigned x, unsigned& nloc, unsigned& nx) {
    const unsigned G = gridDim.x * gridDim.y * gridDim.z;
    unsigned sum, cnt, mine, sp = 0u;
    for (;;) {
        sum = 0u; cnt = 0u; mine = 0u;
#pragma unroll
        for (unsigned j = 0; j < 16; ++j) { const unsigned c = xb_ld(&bar[XB_XCNT(j)]); sum += c; cnt += (c > 0u) ? 1u : 0u; mine = (j == x) ? c : mine; }
        if (sum == G) break;
        __builtin_amdgcn_s_sleep(1);
        if ((++sp & 255u) == 0u) { if (xb_ld(&bar[XB_TMO])) break; if (sp > XB_SPIN_CAP) { atomicAdd(&bar[XB_TMO], 1u); break; } }
    }
    nloc = mine > 0u ? mine : 1u; nx = cnt > 0u ? cnt : 1u;
}

__device__ __forceinline__ void xcd_barrier(const XcdBarrier& b) {
    asm volatile("s_waitcnt vmcnt(0)" ::: "memory");
    __syncthreads();
    if (threadIdx.x == 0) {
        unsigned* bar = b.bar;
        __builtin_amdgcn_s_waitcnt(0);
        unsigned nloc = b.st[0], nx = b.st[1];
        if (nloc == 0u) { xcd_barrier_complete(bar, b.x, nloc, nx); b.st[0] = nloc; b.st[1] = nx; }
        const unsigned old = xb_add(&bar[XB_XSUB(b.x)], 1u);
        const unsigned gen = old / nloc;
        if (old + 1u == (gen + 1u) * nloc) {
            __builtin_amdgcn_fence(__ATOMIC_RELEASE, "agent");
            asm volatile("s_waitcnt vmcnt(0)" ::: "memory");
            const unsigned og = xb_add(&bar[XB_TOP], 1u);
            const unsigned tg = og / nx;
            if (og + 1u == (tg + 1u) * nx) xb_add(&bar[XB_TOPGEN], 1u);
            else XB_SPIN(xb_ld(&bar[XB_TOPGEN]) == tg, bar);
            __builtin_amdgcn_fence(__ATOMIC_ACQUIRE, "agent");
            xb_add(&bar[XB_XGEN(b.x)], 1u);
            asm volatile("s_waitcnt vmcnt(0)" ::: "memory");
        } else {
            XB_SPIN(xb_ld(&bar[XB_XGEN(b.x)]) == gen, bar);
            __builtin_amdgcn_fence(__ATOMIC_ACQUIRE, "agent");
            asm volatile("s_waitcnt vmcnt(0)" ::: "memory");
        }
    }
    __syncthreads();
}

#define ARGTAB_OFF (131072 + 256)
__device__ __forceinline__ const void* arg_ptr(LAS unsigned char* lds, int i) {
    const unsigned long long v = *(const LAS unsigned long long*)(lds + ARGTAB_OFF + 8 * i);
    const unsigned lo = __builtin_amdgcn_readfirstlane((unsigned)v), hi = __builtin_amdgcn_readfirstlane((unsigned)(v >> 32));
    return (const void*)(((unsigned long long)hi << 32) | lo);
}
#define ARG(i) arg_ptr(lds, (i))
#define GRID_SYNC() do { if (STEP < 0) { XcdBarrier xb_; xb_.bar = (unsigned*)ARG(27); xb_.x = xb_xcc_id(); xb_.st = (volatile LAS unsigned*)(lds + 131072); xcd_barrier(xb_); } } while (0)
#define RUNP(p) (STEP < 0 || STEP == 11 * l + (p) - 1)
#define FRESH_IDS() int tid_ = threadIdx.x; asm volatile("" : "+v"(tid_)); const int tid = tid_, lane = tid & 63, wave = __builtin_amdgcn_readfirstlane(tid >> 6), gw = blockIdx.x * NWAVES + wave, gtid = blockIdx.x * NTHREADS + tid; (void)gw; (void)gtid; (void)lane;
#define x_prompt ((const float*)ARG(0))
#define x_sample ((const float*)ARG(1))
#define cache_pool ((const float*)ARG(2))
#define cache_k ((const float*)ARG(3))
#define cache_v ((const float*)ARG(4))
#define cache_conv ((const float*)ARG(5))
#define p_prompt ((const float*)ARG(6))
#define p_sample ((const float*)ARG(7))
#define g_mix ((const float*)ARG(8))
#define w_in ((const float*)ARG(9))
#define b_gate ((const float*)ARG(10))
#define w_pool_grp ((const float*)ARG(11))
#define pool_scale ((const float*)ARG(12))
#define rel_bias ((const float*)ARG(13))
#define w_pool_proj ((const float*)ARG(14))
#define w_attn_proj ((const float*)ARG(15))
#define w_out ((const float*)ARG(16))
#define g_ffn ((const float*)ARG(17))
#define w_up ((const float*)ARG(18))
#define w_dw ((const float*)ARG(19))
#define b_dw ((const float*)ARG(20))
#define w_down ((const float*)ARG(21))
#define g_ple ((const float*)ARG(22))
#define w_ple ((const float*)ARG(23))
#define w_ple_gate ((const float*)ARG(24))
#define g_final ((const float*)ARG(25))
#define HB ((bf16_t*)(ws + WS_HB))
#define MG RP(R_MG)
#define HB3 RP(R_HB3)
#define RP(off) ((bf16_t*)(ws + WS_R + (off)))
#define Ub RP(R_U)
#define Qb RP(R_Q)
#define Kb RP(R_K)
#define Vtb RP(R_VT)
#define Gb RP(R_G)
#define Db RP(R_D)
#define Ksb RP(R_KS)
#define Vtsb RP(R_VTS)
#define Aup RP(R_A)
#define ACT RP(R_ACT)
#define Pb RP(R_PB)
#define Tb RP(R_T)

template <int MODE> struct SGate {
    bf16_t* O; const bf16_t* G; int goff;
    __device__ __forceinline__ void operator()(int row, int col, float v) const {
        bf16_t* op = O + (size_t)row * 1024 + col;
        if (MODE >= 1) v *= bflo(G[(size_t)row * 2048 + goff + col]);
        if (MODE == 2) v += bflo(*op);
        *op = (bf16_t)(cvt_pk_bf16(v, 0.f) & 0xffffu);
    }
};
struct SRes { const float* base; float* Xo; __device__ __forceinline__ void operator()(int row, int col, float v) const { const size_t o = (size_t)row * DM + col; Xo[o] = base[o] + v; } };
struct SPle { const bf16_t* T; float* Xo; __device__ __forceinline__ void operator()(int row, int col, float v) const { const size_t o = (size_t)row * DM + col; Xo[o] += bflo(T[o]) * sigmoidf_(v); } };
template <class F>
__device__ __forceinline__ void small_gemm(LAS unsigned char* lds, const bf16_t* A, const bf16_t* Bt, int K, const F& f) {
    int tid_ = threadIdx.x; asm volatile("" : "+v"(tid_));
    const int tid = tid_, lane = tid & 63, wave = __builtin_amdgcn_readfirstlane(tid >> 6), r = lane & 31, hi = lane >> 5, kw = K >> 3;
    LAS float* red = (LAS float*)lds;
    for (int tile = blockIdx.x; tile < 256; tile += gridDim.x) {
        const int half = (tile >> 3) & 1, q = (tile & 7) + 8 * (tile >> 4), r0 = MP + (q >> 4) * 32, c0 = (2 * (q & 15) + half) * 32;
        const bf16_t* ap = A + (size_t)(r0 + r) * K + wave * kw + 8 * hi; const bf16_t* bp = Bt + (size_t)(c0 + r) * K + wave * kw + 8 * hi;
        f32x16 acc;
#pragma unroll
        for (int i = 0; i < 16; ++i) acc[i] = 0.f;
#pragma unroll 2
        for (int k = 0; k < kw; k += 16) acc = __builtin_amdgcn_mfma_f32_32x32x16_bf16(*(const bf16x8*)(ap + k), *(const bf16x8*)(bp + k), acc, 0, 0, 0);
#pragma unroll
        for (int i = 0; i < 16; ++i) red[(wave * 16 + i) * 64 + lane] = acc[i];
        __syncthreads();
#pragma unroll
        for (int h = 0; h < 2; ++h) { const int e = tid + 512 * h, i = e >> 6, ln = e & 63; float v = 0.f;
#pragma unroll
            for (int w = 0; w < 8; ++w) v += red[w * 1024 + e];
            f(r0 + (i & 3) + 8 * (i >> 2) + 4 * (ln >> 5), c0 + (ln & 31), v); }
        __syncthreads();
    }
}

__device__ __forceinline__ void convert_weights(LAS unsigned char* lds, int l, int vw, int nvw, int wave, int lane) {
    LAS float* scr = (LAS float*)(lds + wave * 16384);
    constexpr int I_IN = 16 * 128, I_AP = 8 * 32, I_OUT = 16 * 32, I_UP = 16 * 176, I_DOWN = 44 * 32, I_PLE = 4 * 32, I_PG = 16 * 32;
    constexpr int I_LAYER = I_IN + I_AP + I_OUT + I_UP + I_DOWN + I_PLE + I_PG;
    unsigned char* wl = (unsigned char*)ARG(27) + WS_W + (size_t)l * WL_SIZE;
    const int nfold = nvw > 1024 ? 256 : 0;
    if (vw >= nfold) for (int it = vw - nfold; it < I_LAYER; it += nvw - nfold) { int rr = it;
        if (rr < I_IN) { transpose_item(w_in + (size_t)l * 1024 * 4096, 1024, 4096, (bf16_t*)(wl + WL_IN), scr, rr, lane); continue; } rr -= I_IN;
        if (rr < I_AP) { transpose_item(w_attn_proj + (size_t)l * 512 * 1024, 512, 1024, (bf16_t*)(wl + WL_AP), scr, rr, lane); continue; } rr -= I_AP;
        if (rr < I_OUT) { transpose_item(w_out + (size_t)l * 1024 * 1024, 1024, 1024, (bf16_t*)(wl + WL_OUT), scr, rr, lane); continue; } rr -= I_OUT;
        if (rr < I_UP) { transpose_item(w_up + (size_t)l * 1024 * 5632, 1024, 5632, (bf16_t*)(wl + WL_UP), scr, rr, lane); continue; } rr -= I_UP;
        if (rr < I_DOWN) { transpose_item(w_down + (size_t)l * 2816 * 1024, 2816, 1024, (bf16_t*)(wl + WL_DOWN), scr, rr, lane); continue; } rr -= I_DOWN;
        if (rr < I_PLE) { transpose_item(w_ple + (size_t)l * 256 * 1024, 256, 1024, (bf16_t*)(wl + WL_PLE), scr, rr, lane); continue; } rr -= I_PLE;
        transpose_item(w_ple_gate + (size_t)l * 1024 * 1024, 1024, 1024, (bf16_t*)(wl + WL_PG), scr, rr, lane);
    }
    if (vw < nfold || nfold == 0) for (int it = vw; it < 256; it += (nfold ? nfold : nvw))
        fold_item(w_pool_grp + (size_t)l * 4 * 128 * 128, pool_scale + l * 512, w_pool_proj + (size_t)l * 512 * 1024, (bf16_t*)(wl + WL_C), it, lane);
}

template <int L, int STEP>
__device__ __forceinline__ void layer_body(LAS unsigned char* lds) {
    constexpr int l = L;
    const int G = gridDim.x, ngw = G * NWAVES, ngt = G * NTHREADS;
#define ws ((unsigned char*)ARG(27))
#define out ((float*)ARG(26))
#define X out

#define WLP(off) ((const bf16_t*)(ws + WS_W + (size_t)l * WL_SIZE + (off)))
#define Win_t WLP(WL_IN)
#define Wc_t WLP(WL_C)
#define Wap_t WLP(WL_AP)
#define Wout_t WLP(WL_OUT)
#define Wup_t WLP(WL_UP)
#define Wdown_t WLP(WL_DOWN)
#define Wple_t WLP(WL_PLE)
#define Wpg_t WLP(WL_PG)
        if (RUNP(1))
        {
        FRESH_IDS();
        norm_rows_bf16(l == 0 ? x_prompt : X, l == 0 ? x_sample : X + (size_t)MP * DM, g_mix + l * DM, HB, gw, ngw, lane);
            const float* ck = cache_k + (size_t)l * DBATCH * KCACHE * 512; const float* cv = cache_v + (size_t)l * DBATCH * KCACHE * 512;
            for (int i = gtid; i < DBATCH * KCACHE * 64; i += ngt) { const int b = i >> 15, rem = i & 32767, rw = rem >> 6, c8 = (rem & 63) * 8;
                const float* s = ck + ((size_t)b * KCACHE + rw) * 512 + c8; const f32x4 a = *(const f32x4*)s, bq = *(const f32x4*)(s + 4);
                *(u32x4*)(Ksb + ((size_t)b * KS_ROWS + rw) * 512 + c8) = pack8(a, bq); }
            for (int it = gw; it < DBATCH * 8 * 64; it += ngw) { const int b = it >> 9, h = (it >> 6) & 7, p0 = (it & 63) * 8;
                float v[8];
#pragma unroll
                for (int j = 0; j < 8; ++j) v[j] = cv[((size_t)b * KCACHE + p0 + j) * 512 + h * 64 + lane];
                u32x4 o; o.x = pk2(v[0], v[1]); o.y = pk2(v[2], v[3]); o.z = pk2(v[4], v[5]); o.w = pk2(v[6], v[7]);
                *(u32x4*)(Vtsb + ((size_t)(b * 8 + h) * 64 + lane) * KS_ROWS + p0) = o; }
        }
        GRID_SYNC();
        if (RUNP(2))
        { Gemm g{HB, Win_t, MT, 4096, 1024}; StaticOrder S; S.init(MT, 4096, G, (int)blockIdx.x);
          EpiG1 E{ws, b_gate + l * 2048, l, out};
          gemm_phase<EpiG1, StaticOrder, true, true>(lds, g, S, E);
          if (l == 0 && STEP < 0) {
              constexpr int nwg = (MT / 256) * 16; int busy = nwg - ((nwg - 1) / G) * G; if (busy >= G) busy = 0;
              if ((int)blockIdx.x >= busy) { FRESH_IDS(); convert_weights(lds, 1, ((int)blockIdx.x - busy) * NWAVES + wave, (G - busy) * NWAVES, wave, lane); } } }
        GRID_SYNC();
        if (RUNP(3))
        {
            FRESH_IDS();
            const float* cp = cache_pool + (size_t)l * DBATCH * 15 * 512;
            for (int i = gtid; i < MT * 64; i += ngt) { const int row = i >> 6, c8 = (i & 63) * 8, w = 2 << (c8 >> 7);
                f32x4 s0 = {0.f, 0.f, 0.f, 0.f}, s1 = s0, u0, u1; float cnt;
                unpack8(*(const u32x4*)(Ub + (size_t)row * 512 + c8), u0, u1);
                if (row < MP) { const int t = row & 2047, n = (t + 1) < w ? (t + 1) : w; cnt = (float)n;
                    s0 = u0; s1 = u1;
#define POOL_TAPS(W) _Pragma("unroll") for (int j = 1; j < (W); ++j) { const bool ok = j <= t; f32x4 a, b; unpack8(*(const u32x4*)(Ub + (size_t)(ok ? row - j : row) * 512 + c8), a, b); const float mk = ok ? 1.f : 0.f; s0 += a * mk; s1 += b * mk; }
                    if (w == 2) { POOL_TAPS(2) } else if (w == 4) { POOL_TAPS(4) } else if (w == 8) { POOL_TAPS(8) } else { POOL_TAPS(16) } }
                else { const int rs = row - MP, b = rs >> 5, t = rs & 31; cnt = (float)w;
                    for (int j = 0; j < w; ++j) { const int tt = t - j; f32x4 a, bq;
                        if (tt >= 0) unpack8(*(const u32x4*)(Ub + (size_t)(row - j) * 512 + c8), a, bq);
                        else { const float* s = cp + ((size_t)b * 15 + 15 + tt) * 512 + c8; a = *(const f32x4*)s; bq = *(const f32x4*)(s + 4); }
                        s0 += a; s1 += bq; } }
                const float ic = 1.0f / cnt;
                *(u32x4*)(Db + (size_t)row * 512 + c8) = pack8(s0 * ic - u0, s1 * ic - u1); }
            LAS float* tball = (LAS float*)lds;
            for (int i = tid; i < 8 * 257; i += NTHREADS) tball[i] = rel_bias[(size_t)l * 8 * 257 + i] * LOG2E;
            __syncthreads();
            const int vcu = (G % 8 == 0) ? ((int)blockIdx.x % 8) * (G / 8) + (int)blockIdx.x / 8 : (int)blockIdx.x;
            for (int ui = vcu * NWAVES + wave; ui < 4096 + 64; ui += ngw) {
                const int h = ui & 7; const LAS float* tb = tball + h * 257;
                if (ui < 4096) { const int bc = ui >> 3, b = bc >> 5, c = bc & 31; const long row0 = (long)b * SEQ + c * 64, krow0 = (long)b * SEQ + (long)(c - 8) * 64;
                    attn_unit<2>(Qb + row0 * 512 + h * 64, Kb + krow0 * 512 + h * 64, Vtb + ((long)(b * 8 + h) * 64) * SEQ + (long)(c - 8) * 64, SEQ, c < 8 ? (8 - c) * 2 : 0, 18, 512, tb, Qb + row0 * 512 + h * 64, lane); }
                else { const int b = (ui - 4096) >> 3; const long row0 = (long)MP + b * DSEQ;
                    attn_unit<1>(Qb + row0 * 512 + h * 64, Ksb + (long)b * KS_ROWS * 512 + h * 64, Vtsb + ((long)(b * 8 + h) * 64) * KS_ROWS, KS_ROWS, 0, 17, 512, tb, Qb + row0 * 512 + h * 64, lane); }
            }
        }
        GRID_SYNC();
        if (RUNP(4))
        { StaticOrder S; S.init(MP, 1024, G, (int)blockIdx.x);
          { Gemm g{Db, Wc_t, MP, 1024, 512}; EpiGate<1> E{MG, 1024, Gb, 0}; gemm_phase<EpiGate<1>, StaticOrder, true, true>(lds, g, S, E); }
          { Gemm g{Qb, Wap_t, MP, 1024, 512}; EpiGate<2> E{MG, 1024, Gb, 1024}; gemm_phase<EpiGate<2>, StaticOrder, true, true>(lds, g, S, E); }
          small_gemm(lds, Db, Wc_t, 512, SGate<1>{MG, Gb, 0}); small_gemm(lds, Qb, Wap_t, 512, SGate<2>{MG, Gb, 1024}); }
        GRID_SYNC();
        if (RUNP(5))
        { Gemm g{MG, Wout_t, MP, 1024, 1024}; StaticOrder S; S.init(MP, 1024, G, (int)blockIdx.x);
          EpiRes E{l == 0 ? x_prompt : X, l == 0 ? x_sample : X + (size_t)MP * DM, X}; gemm_phase<EpiRes, StaticOrder, true, true>(lds, g, S, E);
          small_gemm(lds, MG, Wout_t, 1024, SRes{l == 0 ? x_sample - (size_t)MP * DM : X, X}); }
        GRID_SYNC();
        if (RUNP(6))
        { FRESH_IDS(); norm_rows_bf16(X, X + (size_t)MP * DM, g_ffn + l * DM, HB, gw, ngw, lane); }
        GRID_SYNC();
        if (RUNP(7))
        { Gemm g{HB, Wup_t, MT, 2816, 1024}; StaticOrder S; S.init(MT, 2816, G, (int)blockIdx.x);
          EpiUpA E{Aup, out, l}; gemm_phase<EpiUpA, StaticOrder, true, true>(lds, g, S, E); }
        GRID_SYNC();
        if (RUNP(8))
        { Gemm g{HB, Wup_t + (size_t)2816 * 1024, MT, 2816, 1024}; StaticOrder S; S.init(MT, 2816, G, (int)blockIdx.x);
          EpiUpB E{Aup, ACT, w_dw + (size_t)l * 3 * DFF, b_dw + (size_t)l * DFF, cache_conv + (size_t)l * DBATCH * 2 * DFF}; gemm_phase<EpiUpB, StaticOrder, true, true>(lds, g, S, E); }
        GRID_SYNC();
        if (RUNP(9))
        { Gemm g{ACT, Wdown_t, MP, 1024, 2816}; StaticOrder S; S.init(MP, 1024, G, (int)blockIdx.x);
          EpiRes E{X, X + (size_t)MP * DM, X}; gemm_phase<EpiRes, StaticOrder, true, true>(lds, g, S, E);
          small_gemm(lds, ACT, Wdown_t, 2816, SRes{X, X}); }
        GRID_SYNC();
        if (RUNP(10))
        { FRESH_IDS(); norm_rows_bf16(X, X + (size_t)MP * DM, g_ple + l * DM, HB3, gw, ngw, lane);
          const float* pp = p_prompt + (size_t)l * MP * 256; const float* ps = p_sample + (size_t)l * MS * 256;
          for (int i = gtid; i < MT * 32; i += ngt) { const size_t e = (size_t)i * 8; const float* s = e < (size_t)MP * 256 ? pp + e : ps + (e - (size_t)MP * 256);
              const f32x4 a = *(const f32x4*)s, b = *(const f32x4*)(s + 4); *(u32x4*)(Pb + e) = pack8(a, b); } }
        GRID_SYNC();
        if (RUNP(11))
        { StaticOrder S; S.init(MP, 1024, G, (int)blockIdx.x);
          { Gemm g{Pb, Wple_t, MP, 1024, 256}; EpiGate<0> E{Tb, 1024, nullptr, 0}; gemm_phase<EpiGate<0>, StaticOrder, true, true>(lds, g, S, E); }
          { Gemm g{HB3, Wpg_t, MP, 1024, 1024}; EpiPle E{Tb, X}; gemm_phase<EpiPle, StaticOrder, true, true>(lds, g, S, E); }
          small_gemm(lds, Pb, Wple_t, 256, SGate<0>{Tb, nullptr, 0}); small_gemm(lds, HB3, Wpg_t, 1024, SPle{Tb, X}); }
        GRID_SYNC();

}

template <int STEP>
__global__ void __launch_bounds__(NTHREADS, 2) mega_fwd(Args args) {
    extern __shared__ __attribute__((aligned(16))) unsigned char lds_raw[];
    LAS unsigned char* lds = (LAS unsigned char*)lds_raw;
    cg::grid_group grid = cg::this_grid();
    const int G = gridDim.x, ngw = G * NWAVES, ngt = G * NTHREADS;
    for (int u = threadIdx.x; u < 64; u += NTHREADS) ((LAS unsigned*)(lds + 131072))[u] = 0u;
    __syncthreads();
    if (threadIdx.x == 0) { LAS unsigned long long* tab = (LAS unsigned long long*)(lds + ARGTAB_OFF);
        tab[0] = (unsigned long long)args.in[0];
        tab[1] = (unsigned long long)args.in[1];
        tab[2] = (unsigned long long)args.in[2];
        tab[3] = (unsigned long long)args.in[3];
        tab[4] = (unsigned long long)args.in[4];
        tab[5] = (unsigned long long)args.in[5];
        tab[6] = (unsigned long long)args.in[6];
        tab[7] = (unsigned long long)args.in[7];
        tab[8] = (unsigned long long)args.in[8];
        tab[9] = (unsigned long long)args.in[9];
        tab[10] = (unsigned long long)args.in[10];
        tab[11] = (unsigned long long)args.in[11];
        tab[12] = (unsigned long long)args.in[12];
        tab[13] = (unsigned long long)args.in[13];
        tab[14] = (unsigned long long)args.in[14];
        tab[15] = (unsigned long long)args.in[15];
        tab[16] = (unsigned long long)args.in[16];
        tab[17] = (unsigned long long)args.in[17];
        tab[18] = (unsigned long long)args.in[18];
        tab[19] = (unsigned long long)args.in[19];
        tab[20] = (unsigned long long)args.in[20];
        tab[21] = (unsigned long long)args.in[21];
        tab[22] = (unsigned long long)args.in[22];
        tab[23] = (unsigned long long)args.in[23];
        tab[24] = (unsigned long long)args.in[24];
        tab[25] = (unsigned long long)args.in[25];
        tab[26] = (unsigned long long)args.p_out; tab[27] = (unsigned long long)args.p_ws; }
    __syncthreads();
    if (STEP < 0) { (void)xcd_barrier_post((unsigned*)ARG(27), (volatile LAS unsigned*)(lds + 131072)); grid.sync(); }
    if (STEP < 0 || STEP == 0) {
        FRESH_IDS();
        convert_weights(lds, 0, gw, ngw, wave, lane);
        if (STEP >= 0) convert_weights(lds, 1, gw, ngw, wave, lane);
    }

    layer_body<0, STEP>(lds);
    layer_body<1, STEP>(lds);
    if (STEP < 0 || STEP == 22)
    { FRESH_IDS(); norm_rows_f32(X, g_final, gw, ngw, lane); }
}

#undef ws
#undef out
#undef X
extern "C" void kernel_launch(void* const* d_in, const int* in_sizes, int n_in, void* d_out, int out_size, void* d_ws, size_t ws_size, hipStream_t stream) {
    static int grid = 0;
    if (grid == 0) {
        if (n_in != 26 || (size_t)out_size != O_END || ws_size < WS_END) { fprintf(stderr, "kernel_launch: unexpected shapes: n_in %d out %d ws %zu (need %zu)\n", n_in, out_size, ws_size, (size_t)WS_END); grid = -1; return; }
        int dev = 0, cus = 0, per_cu = 0;
        hipGetDevice(&dev); hipDeviceGetAttribute(&cus, hipDeviceAttributeMultiprocessorCount, dev);
        if (hipFuncSetAttribute((const void*)mega_fwd<-1>, hipFuncAttributeMaxDynamicSharedMemorySize, LDS_BYTES) != hipSuccess) { fprintf(stderr, "kernel_launch: hipFuncSetAttribute failed\n"); grid = -1; return; }
        if (hipOccupancyMaxActiveBlocksPerMultiprocessor(&per_cu, (const void*)mega_fwd<-1>, NTHREADS, LDS_BYTES) != hipSuccess || per_cu < 1) { fprintf(stderr, "kernel_launch: occupancy query gives %d\n", per_cu); grid = -1; (void)hipGetLastError(); return; }
        grid = cus;
#if !ONE_LAUNCH
        { typedef void (*kfn)(Args);
          const kfn fa[23] = {mega_fwd<0>, mega_fwd<1>, mega_fwd<2>, mega_fwd<3>, mega_fwd<4>, mega_fwd<5>, mega_fwd<6>, mega_fwd<7>, mega_fwd<8>, mega_fwd<9>, mega_fwd<10>, mega_fwd<11>,
                              mega_fwd<12>, mega_fwd<13>, mega_fwd<14>, mega_fwd<15>, mega_fwd<16>, mega_fwd<17>, mega_fwd<18>, mega_fwd<19>, mega_fwd<20>, mega_fwd<21>, mega_fwd<22>};
          for (int i = 0; i < 23; ++i) if (hipFuncSetAttribute((const void*)fa[i], hipFuncAttributeMaxDynamicSharedMemorySize, LDS_BYTES) != hipSuccess) { fprintf(stderr, "kernel_launch: hipFuncSetAttribute failed for step %d\n", i); grid = -1; return; } }
#endif
    }
    if (grid < 0) return;
    if (hipMemsetAsync(d_ws, 0, 65536, stream) != hipSuccess) { fprintf(stderr, "memset failed\n"); return; }
    Args a{};
    for (int i = 0; i < 26; ++i) a.in[i] = (const float*)d_in[i];
    a.p_out = (float*)d_out; a.p_ws = (unsigned char*)d_ws;
    void* kargs[] = {&a};
#if ONE_LAUNCH
    hipError_t e = hipLaunchCooperativeKernel((const void*)mega_fwd<-1>, dim3(grid), dim3(NTHREADS), kargs, LDS_BYTES, stream);
    if (e != hipSuccess) fprintf(stderr, "cooperative launch failed: %s (grid %d)\n", hipGetErrorString(e), grid);
#else
    typedef void (*kfn)(Args);
    static const kfn fns[23] = {mega_fwd<0>, mega_fwd<1>, mega_fwd<2>, mega_fwd<3>, mega_fwd<4>, mega_fwd<5>, mega_fwd<6>, mega_fwd<7>, mega_fwd<8>, mega_fwd<9>, mega_fwd<10>, mega_fwd<11>,
                                mega_fwd<12>, mega_fwd<13>, mega_fwd<14>, mega_fwd<15>, mega_fwd<16>, mega_fwd<17>, mega_fwd<18>, mega_fwd<19>, mega_fwd<20>, mega_fwd<21>, mega_fwd<22>};
    for (int st = 0; st < 23; ++st) hipLaunchKernelGGL(fns[st], dim3(grid), dim3(NTHREADS), LDS_BYTES, stream, a);
#endif
}
```
